# Optimizing an MI355X kernel written in HIP

```python
import math
import jax
import jax.numpy as jnp
from jax import lax
import numpy as np

D_MODEL = 1024
BATCH = 8
SEQ = 4096
DEPTH = 4

GRID_W = 64
CTX_LEN = 256
EPS = 1e-6

MIX_W = D_MODEL
S5_W = D_MODEL // 4
S5_GROUP = 16
S5_GROUPS = S5_W // S5_GROUP
S5_STATE = 64
MLA_V = 64
MLA_W = D_MODEL // 2
MLA_HEADS = MLA_W // MLA_V
MLA_NOPE = 64
MLA_ROPE = 32
MLA_Q_RANK = 384
MLA_KV_RANK = 256
MLA_SCALE = 1.0 / math.sqrt(MLA_NOPE + MLA_ROPE)
ROPE_BASE = 10000.0
Q_BLOCK = 128
HY_W = D_MODEL // 4
HY_ORDER = 2
HY_POS_EMB = 33
HY_FILTER_W = 64
HY_MIN_DECAY = math.log(1e-2) / 1.5
HY_MAX_DECAY = math.log(1e-2) / 0.3
P_IN = S5_W + MLA_Q_RANK + MLA_KV_RANK + MLA_ROPE + 3 * HY_W
MOE_GROUPS = 4
MOE_PER_GROUP = 8
MOE_EXPERTS = MOE_GROUPS * MOE_PER_GROUP
MOE_TOP_K = 2
MOE_HIDDEN = 512
MOE_BLOCK = 256

kernel_name = 'hybrid_s5_mla_hyena_hmoe_diffusion'


def _rms_norm(x, g):
    xf = x.astype(jnp.float32)
    y = xf * lax.rsqrt(jnp.mean(xf * xf, axis=-1, keepdims=True) + EPS)
    return (y * g.astype(jnp.float32)).astype(x.dtype)


def _modulate(x, g, shift, scale):
    return _rms_norm(x, g) * (1.0 + scale) + shift


def _split_projection(p):
    o1 = S5_W
    o2 = o1 + MLA_Q_RANK
    o3 = o2 + MLA_KV_RANK
    o4 = o3 + MLA_ROPE
    return p[..., :o1], p[..., o1:o2], p[..., o2:o3], p[..., o3:o4], p[..., o4:]


def _s5_discretise(lam_re, lam_im, log_dt, b_re, b_im):
    lam = lax.complex(lam_re.astype(jnp.float32), lam_im.astype(jnp.float32))
    dt = jnp.exp(log_dt.astype(jnp.float32))[..., None]
    lam_bar = jnp.exp(lam * dt)
    b = lax.complex(b_re.astype(jnp.float32), b_im.astype(jnp.float32))
    b_bar = ((lam_bar - 1.0) / lam)[..., None] * b
    return lam_bar, b_bar


def _diag_scan(lam_bar, bu, reverse):
    a = jnp.broadcast_to(lam_bar, bu.shape)

    def combine(e1, e2):
        a1, b1 = e1
        a2, b2 = e2
        return a1 * a2, a2 * b1 + b2

    return lax.associative_scan(combine, (a, bu), reverse=reverse, axis=1)[1]


def _s5_mixer(u_l, u_c, lam_re, lam_im, log_dt, b_re, b_im, c_re, c_im, d, glu_w, ctx_out):
    lam_bar, b_bar = _s5_discretise(lam_re, lam_im, log_dt, b_re, b_im)
    c = lax.complex(c_re.astype(jnp.float32), c_im.astype(jnp.float32))

    def drive(u):
        ug = u.astype(jnp.float32).reshape(u.shape[0], u.shape[1], S5_GROUPS, S5_GROUP).astype(jnp.complex64)
        return [jnp.einsum('blgh,gph->blgp', ug, b_bar[k]) for k in range(2)]

    bu_c = drive(u_c)
    bu_l = drive(u_l)
    hc_f = _diag_scan(lam_bar[0], bu_c[0], False)
    hc_b = _diag_scan(lam_bar[1], bu_c[1], True)
    hl_f = _diag_scan(lam_bar[0], bu_l[0].at[:, 0].add(lam_bar[0] * hc_f[:, -1]), False)
    hl_b = _diag_scan(lam_bar[1], bu_l[1].at[:, -1].add(lam_bar[1] * hc_b[:, 0]), True)

    def readout(u, h_f, h_b):
        y = jnp.real(jnp.einsum('blgp,ghp->blgh', h_f, c[0]) + jnp.einsum('blgp,ghp->blgh', h_b, c[1]))
        y = y.reshape(u.shape) + d.astype(jnp.float32) * u.astype(jnp.float32)
        y = jax.nn.gelu(y)
        return (y * jax.nn.sigmoid(y @ glu_w.astype(jnp.float32))).astype(u.dtype)

    y_l = readout(u_l, hl_f, hl_b)
    y_c = readout(u_c, hc_f, hc_b) if ctx_out else None
    return y_l, y_c


def _axial_rope_tables(n_tokens):
    rows = n_tokens // GRID_W
    row = jnp.repeat(jnp.arange(rows), GRID_W).astype(jnp.float32)
    col = jnp.tile(jnp.arange(GRID_W), rows).astype(jnp.float32)
    half = MLA_ROPE // 2
    inv = ROPE_BASE ** (-jnp.arange(0, half, 2, dtype=jnp.float32) / half)
    ang_r = row[:, None] * inv
    ang_c = col[:, None] * inv
    return jnp.cos(ang_r), jnp.sin(ang_r), jnp.cos(ang_c), jnp.sin(ang_c)


def _rotate(x, cos, sin):
    m = x.shape[-1] // 2
    x1, x2 = x[..., :m], x[..., m:]
    return jnp.concatenate([x1 * cos - x2 * sin, x1 * sin + x2 * cos], axis=-1)


def _axial_rope(x, tables):
    cr, sr, cc, sc = (t[:, None, :].astype(x.dtype) for t in tables)
    half = MLA_ROPE // 2
    return jnp.concatenate([_rotate(x[..., :half], cr, sr), _rotate(x[..., half:], cc, sc)], axis=-1)


def _mla_attend(q_nope, q_rope, k_nope, k_rope, v):
    s = jnp.einsum('bqhd,bkhd->bhqk', q_nope, k_nope) + jnp.einsum('bqhr,bkr->bhqk', q_rope, k_rope)
    p = jax.nn.softmax(s.astype(jnp.float32) * MLA_SCALE, axis=-1).astype(v.dtype)
    return jnp.einsum('bhqk,bkhd->bqhd', p, v)


def _mla_mixer(cq_l, ckv_l, kr_l, cq_c, ckv_c, kr_c, q_norm_g, kv_norm_g, w_uq, w_ukv, ctx_out):
    def queries(cq):
        q = (_rms_norm(cq, q_norm_g) @ w_uq).reshape(cq.shape[0], cq.shape[1], MLA_HEADS, MLA_NOPE + MLA_ROPE)
        return q[..., :MLA_NOPE], q[..., MLA_NOPE:]

    def keys_values(ckv):
        kv = (_rms_norm(ckv, kv_norm_g) @ w_ukv).reshape(ckv.shape[0], ckv.shape[1], MLA_HEADS, MLA_NOPE + MLA_V)
        return kv[..., :MLA_NOPE], kv[..., MLA_NOPE:]

    bsz, n = cq_l.shape[0], cq_l.shape[1]
    tables = _axial_rope_tables(n)
    kn_c, v_c = keys_values(ckv_c)
    kn_l, v_l = keys_values(ckv_l)
    kr_lat = _axial_rope(kr_l[:, :, None, :], tables)[:, :, 0]
    qn_l, qr_l = queries(cq_l)
    qr_l = _axial_rope(qr_l, tables)
    k_nope = jnp.concatenate([kn_c, kn_l], axis=1)
    k_rope = jnp.concatenate([kr_c, kr_lat], axis=1)
    v = jnp.concatenate([v_c, v_l], axis=1)
    nblk = n // Q_BLOCK

    def to_blocks(q):
        return q.reshape(bsz, nblk, Q_BLOCK, q.shape[2], q.shape[3]).swapaxes(0, 1)

    o = lax.map(lambda qb: _mla_attend(qb[0], qb[1], k_nope, k_rope, v), (to_blocks(qn_l), to_blocks(qr_l)))
    y_l = o.swapaxes(0, 1).reshape(bsz, n, MLA_W)
    y_c = None
    if ctx_out:
        qn_c, qr_c = queries(cq_c)
        y_c = _mla_attend(qn_c, qr_c, kn_c, kr_c, v_c).reshape(bsz, kr_c.shape[1], MLA_W)
    return y_l, y_c


def _short_conv(z, w, b):
    n = z.shape[1]
    zp = jnp.pad(z, ((0, 0), (1, 1), (0, 0)))
    return zp[:, :n] * w[0] + zp[:, 1:n + 1] * w[1] + zp[:, 2:] * w[2] + b


def _hyena_filter_spectrum(n, w1, b1, w2, b2, w3, b3, freq):
    t = jnp.linspace(0.0, 1.0, n, dtype=jnp.float32)[:, None]
    bands = (HY_POS_EMB - 1) // 2
    f = jnp.linspace(1e-4, bands - 1, bands, dtype=jnp.float32)
    ang = (2.0 * math.pi * jnp.arange(n, dtype=jnp.float32) / n)[:, None] * f
    z = jnp.concatenate([t, jnp.cos(ang), -jnp.sin(ang)], axis=-1)
    h = jnp.sin(freq[0] * (z @ w1 + b1))
    h = jnp.sin(freq[1] * (h @ w2 + b2))
    h = (h @ w3 + b3).astype(jnp.float32).reshape(n, 2, HY_ORDER, HY_W)
    deltas = jnp.abs(jnp.linspace(HY_MIN_DECAY, HY_MAX_DECAY, HY_W, dtype=jnp.float32))
    h = h * jnp.exp(-t[:, :, None, None] * deltas)
    fwd, bwd = h[:, 0], h[:, 1]
    k = jnp.concatenate([fwd, jnp.zeros((1, HY_ORDER, HY_W), jnp.float32), bwd[:0:-1]], axis=0)
    return jnp.fft.rfft(k, axis=0)


def _fft_long_conv(y, k_f):
    n = y.shape[1]
    yf = jnp.fft.rfft(y, n=2 * n, axis=1)
    return jnp.fft.irfft(yf * k_f, n=2 * n, axis=1)[:, :n]


def _hyena_mixer(z, short_w, short_b, filt, bias):
    n = z.shape[1]
    z = _short_conv(z, short_w, short_b)
    v, x1, x2 = jnp.split(z, 3, axis=-1)
    k_f = _hyena_filter_spectrum(n, *filt)
    y = v.astype(jnp.float32)
    for o, gate in enumerate((x1, x2)):
        y = gate.astype(jnp.float32) * (_fft_long_conv(y, k_f[:, o]) + y * bias[o].astype(jnp.float32))
    return y.astype(z.dtype)


def _merge_groups(y_s5, y_mla, y_hy, g):
    return jnp.concatenate([
        _rms_norm(y_s5, g[:S5_W]),
        _rms_norm(y_mla, g[S5_W:S5_W + MLA_W]),
        _rms_norm(y_hy, g[S5_W + MLA_W:]),
    ], axis=-1)


def _hier_moe(h, w_group, w_expert, w1, w3, w2):
    t, d = h.shape
    g_prob = jax.nn.softmax((h @ w_group).astype(jnp.float32), axis=-1)
    g_w, g_idx = lax.top_k(g_prob, 1)
    e_logits = (h @ w_expert).astype(jnp.float32).reshape(t, MOE_GROUPS, MOE_PER_GROUP)
    in_group = jnp.take_along_axis(e_logits, g_idx[:, :, None], axis=1)[:, 0]
    top_v, top_i = lax.top_k(in_group, MOE_TOP_K)
    gate = jax.nn.softmax(top_v, axis=-1) * g_w
    eid = g_idx * MOE_PER_GROUP + top_i
    n_assign = t * MOE_TOP_K
    flat_e = eid.reshape(n_assign)
    order = jnp.argsort(flat_e)
    se = flat_e[order]
    st = (order // MOE_TOP_K).astype(jnp.int32)
    sw = gate.reshape(n_assign)[order]
    counts = jnp.bincount(flat_e, length=MOE_EXPERTS)
    padded = (counts + MOE_BLOCK - 1) // MOE_BLOCK * MOE_BLOCK
    start = jnp.cumsum(counts) - counts
    pend = jnp.cumsum(padded)
    pstart = pend - padded
    dest = pstart[se] + jnp.arange(n_assign) - start[se]
    n_blocks = -(-n_assign // MOE_BLOCK) + MOE_EXPERTS
    n_rows = n_blocks * MOE_BLOCK
    row_tok = jnp.zeros((n_rows,), jnp.int32).at[dest].set(st)
    row_w = jnp.zeros((n_rows,), jnp.float32).at[dest].set(sw)
    block_e = jnp.minimum(jnp.searchsorted(pend, jnp.arange(n_blocks) * MOE_BLOCK, side='right'), MOE_EXPERTS - 1)

    def expert_block(args):
        xb, e = args
        return (jax.nn.silu(xb @ w1[e]) * (xb @ w3[e])) @ w2[e]

    ys = lax.map(expert_block, (h[row_tok].reshape(n_blocks, MOE_BLOCK, d), block_e))
    ys = ys.reshape(n_rows, d) * row_w[:, None].astype(h.dtype)
    return jnp.zeros_like(h).at[row_tok].add(ys)


def setup_inputs(seed: int = 0) -> dict:
    key = jax.random.key(seed)
    ks = iter(jax.random.split(key, 48))

    def nrm(shape, scale):
        return scale * jax.random.normal(next(ks), shape, jnp.float32)

    D = D_MODEL
    G, P, H = S5_GROUPS, S5_STATE, S5_GROUP
    inp = {}
    inp['x'] = nrm((BATCH, SEQ, D), 1.0)
    inp['c'] = nrm((BATCH, D), 1.0)
    inp['ctx'] = nrm((BATCH, CTX_LEN, D), 1.0)
    inp['c_ctx'] = nrm((D,), 1.0)
    inp['ada_w'] = nrm((DEPTH, D, 6 * D), 0.5 * D ** -0.5)
    inp['ada_b'] = nrm((DEPTH, 6 * D), 0.02)
    inp['norm1_g'] = 1.0 + nrm((DEPTH, D), 0.02)
    inp['norm2_g'] = 1.0 + nrm((DEPTH, D), 0.02)
    inp['w_in'] = nrm((DEPTH, D, P_IN), D ** -0.5)
    inp['s5_lambda_re'] = -0.5 + nrm((DEPTH, 2, G, P), 0.01)
    inp['s5_lambda_im'] = math.pi * jnp.arange(P, dtype=jnp.float32) + nrm((DEPTH, 2, G, P), 0.01)
    inp['s5_log_dt'] = jax.random.uniform(next(ks), (DEPTH, 2, G), jnp.float32, math.log(1e-3), math.log(1e-1))
    inp['s5_b_re'] = nrm((DEPTH, 2, G, P, H), (2 * H) ** -0.5)
    inp['s5_b_im'] = nrm((DEPTH, 2, G, P, H), (2 * H) ** -0.5)
    inp['s5_c_re'] = nrm((DEPTH, 2, G, H, P), (2 * P) ** -0.5)
    inp['s5_c_im'] = nrm((DEPTH, 2, G, H, P), (2 * P) ** -0.5)
    inp['s5_d'] = nrm((DEPTH, S5_W), 1.0)
    inp['s5_glu_w'] = nrm((DEPTH, S5_W, S5_W), S5_W ** -0.5)
    inp['mla_q_norm_g'] = 1.0 + nrm((DEPTH, MLA_Q_RANK), 0.02)
    inp['mla_kv_norm_g'] = 1.0 + nrm((DEPTH, MLA_KV_RANK), 0.02)
    inp['mla_w_uq'] = nrm((DEPTH, MLA_Q_RANK, MLA_HEADS * (MLA_NOPE + MLA_ROPE)), MLA_Q_RANK ** -0.5)
    inp['mla_w_ukv'] = nrm((DEPTH, MLA_KV_RANK, MLA_HEADS * (MLA_NOPE + MLA_V)), MLA_KV_RANK ** -0.5)
    inp['hy_short_w'] = nrm((DEPTH, 3, 3 * HY_W), 3 ** -0.5)
    inp['hy_short_b'] = nrm((DEPTH, 3 * HY_W), 0.02)
    inp['hy_f_w1'] = nrm((DEPTH, HY_POS_EMB, HY_FILTER_W), HY_POS_EMB ** -0.5)
    inp['hy_f_b1'] = nrm((DEPTH, HY_FILTER_W), 0.02)
    inp['hy_f_w2'] = nrm((DEPTH, HY_FILTER_W, HY_FILTER_W), HY_FILTER_W ** -0.5)
    inp['hy_f_b2'] = nrm((DEPTH, HY_FILTER_W), 0.02)
    inp['hy_f_w3'] = nrm((DEPTH, HY_FILTER_W, 2 * HY_ORDER * HY_W), 0.1 * HY_FILTER_W ** -0.5)
    inp['hy_f_b3'] = nrm((DEPTH, 2 * HY_ORDER * HY_W), 0.002)
    inp['hy_f_freq'] = 1.0 + nrm((DEPTH, 2, HY_FILTER_W), 0.02)
    inp['hy_bias'] = nrm((DEPTH, HY_ORDER, HY_W), 1.0)
    inp['mix_norm_g'] = 1.0 + nrm((DEPTH, MIX_W), 0.02)
    inp['w_out'] = nrm((DEPTH, MIX_W, D), MIX_W ** -0.5)
    inp['moe_w_group'] = nrm((DEPTH, D, MOE_GROUPS), D ** -0.5)
    inp['moe_w_expert'] = nrm((DEPTH, D, MOE_EXPERTS), D ** -0.5)
    inp['moe_w1'] = nrm((DEPTH, MOE_EXPERTS, D, MOE_HIDDEN), D ** -0.5)
    inp['moe_w3'] = nrm((DEPTH, MOE_EXPERTS, D, MOE_HIDDEN), D ** -0.5)
    inp['moe_w2'] = nrm((DEPTH, MOE_EXPERTS, MOE_HIDDEN, D), MOE_HIDDEN ** -0.5)
    inp['final_g'] = 1.0 + nrm((D,), 0.02)
    return inp


def reference(x, c, ctx, c_ctx, ada_w, ada_b, norm1_g, norm2_g, w_in,
              s5_lambda_re, s5_lambda_im, s5_log_dt, s5_b_re, s5_b_im, s5_c_re, s5_c_im, s5_d, s5_glu_w,
              mla_q_norm_g, mla_kv_norm_g, mla_w_uq, mla_w_ukv,
              hy_short_w, hy_short_b, hy_f_w1, hy_f_b1, hy_f_w2, hy_f_b2, hy_f_w3, hy_f_b3, hy_f_freq, hy_bias,
              mix_norm_g, w_out, moe_w_group, moe_w_expert, moe_w1, moe_w3, moe_w2, final_g):
    bsz, n, d = x.shape
    n_ctx = ctx.shape[1]
    xl, xc = x, ctx
    act_l = jax.nn.silu(c)
    act_c = jax.nn.silu(c_ctx)
    for i in range(DEPTH):
        ctx_out = i < DEPTH - 1
        mod_l = jnp.split((act_l @ ada_w[i] + ada_b[i])[:, None, :], 6, axis=-1)
        mod_c = jnp.split((act_c @ ada_w[i] + ada_b[i])[None, None, :], 6, axis=-1)
        hl = _modulate(xl, norm1_g[i], mod_l[0], mod_l[1])
        hc = _modulate(xc, norm1_g[i], mod_c[0], mod_c[1])
        u_l, cq_l, ckv_l, kr_l, hz_l = _split_projection(hl @ w_in[i])
        u_c, cq_c, ckv_c, kr_c, hz_c = _split_projection(hc @ w_in[i])
        s5_l, s5_c = _s5_mixer(u_l, u_c, s5_lambda_re[i], s5_lambda_im[i], s5_log_dt[i], s5_b_re[i], s5_b_im[i],
                               s5_c_re[i], s5_c_im[i], s5_d[i], s5_glu_w[i], ctx_out)
        mla_l, mla_c = _mla_mixer(cq_l, ckv_l, kr_l, cq_c, ckv_c, kr_c, mla_q_norm_g[i], mla_kv_norm_g[i],
                                  mla_w_uq[i], mla_w_ukv[i], ctx_out)
        filt = (hy_f_w1[i], hy_f_b1[i], hy_f_w2[i], hy_f_b2[i], hy_f_w3[i], hy_f_b3[i], hy_f_freq[i])
        hy_l = _hyena_mixer(hz_l, hy_short_w[i], hy_short_b[i], filt, hy_bias[i])
        xl = xl + mod_l[2] * (_merge_groups(s5_l, mla_l, hy_l, mix_norm_g[i]) @ w_out[i])
        fl = _modulate(xl, norm2_g[i], mod_l[3], mod_l[4]).reshape(bsz * n, d)
        if ctx_out:
            hy_c = _hyena_mixer(hz_c, hy_short_w[i], hy_short_b[i], filt, hy_bias[i])
            xc = xc + mod_c[2] * (_merge_groups(s5_c, mla_c, hy_c, mix_norm_g[i]) @ w_out[i])
            fc = _modulate(xc, norm2_g[i], mod_c[3], mod_c[4]).reshape(bsz * n_ctx, d)
            y = _hier_moe(jnp.concatenate([fl, fc], axis=0), moe_w_group[i], moe_w_expert[i],
                          moe_w1[i], moe_w3[i], moe_w2[i])
            xl = xl + mod_l[5] * y[:bsz * n].reshape(bsz, n, d)
            xc = xc + mod_c[5] * y[bsz * n:].reshape(bsz, n_ctx, d)
        else:
            y = _hier_moe(fl, moe_w_group[i], moe_w_expert[i], moe_w1[i], moe_w3[i], moe_w2[i])
            xl = xl + mod_l[5] * y.reshape(bsz, n, d)
    return _rms_norm(xl, final_g)
```

```cpp
#include <hip/hip_runtime.h>
#include <cstdio>
#include <cstdint>

#define LAS __attribute__((address_space(3)))
#define GAS __attribute__((address_space(1)))
typedef unsigned short bf16_t;
typedef short bf16x8 __attribute__((ext_vector_type(8)));
typedef short s16x4 __attribute__((ext_vector_type(4)));
typedef float f32x4 __attribute__((ext_vector_type(4)));
typedef float f32x2 __attribute__((ext_vector_type(2)));
typedef float f32x16 __attribute__((ext_vector_type(16)));
typedef unsigned u32x4 __attribute__((ext_vector_type(4)));
typedef unsigned u32x2 __attribute__((ext_vector_type(2)));

constexpr int DM = 1024, NB = 8, SEQ = 4096, NLAYER = 4, CTXL = 256;
constexpr int TL = NB * SEQ;
constexpr int TC = NB * CTXL;
constexpr int TT = TL + TC;
constexpr int PW = 1792;
constexpr int P_U = 0, P_CQ = 256, P_CKV = 640, P_KR = 896, P_HZ = 928, P_IN = 1696;
constexpr int NHEAD = 8, DQK = 96, DV = 64, QW = NHEAD * DQK  , KVW = NHEAD * 128  ;
constexpr int NKEY = CTXL + SEQ;
constexpr int S5G = 16, S5H = 16, S5P = 64, S5LC = 64, S5NCH = NKEY / S5LC  , S5ROWS = NB * S5NCH  , S5ROWSP = 768, S5K = 1280;
constexpr int HYW = 256, HYN2 = 8192;
constexpr int NEXP = 32, MOEH = 512, MOE_MAXTILES = 304, MOE_MAXROWS = MOE_MAXTILES * 256;
constexpr float EPS = 1e-6f;
constexpr int NWAVES = 8, NTHR = 512;

#define LDS_WAIT() asm volatile("s_waitcnt lgkmcnt(0)" ::: "memory")
#define VM_WAIT() asm volatile("s_waitcnt vmcnt(0)" ::: "memory")
__device__ __forceinline__ unsigned cvt_pk_bf16(float lo, float hi) { unsigned r; asm volatile("v_cvt_pk_bf16_f32 %0, %1, %2" : "=v"(r) : "v"(lo), "v"(hi)); return r; }
__device__ __forceinline__ float bf2f(unsigned short h) { return __uint_as_float(((unsigned)h) << 16); }
__device__ __forceinline__ float bflo(unsigned w) { return __uint_as_float(w << 16); }
__device__ __forceinline__ float bfhi(unsigned w) { return __uint_as_float(w & 0xffff0000u); }
__device__ __forceinline__ unsigned short f2bf(float f) { return (unsigned short)(cvt_pk_bf16(f, 0.f) & 0xffffu); }
__device__ __forceinline__ float wave_sum(float v) {
#pragma unroll
    for (int o = 1; o < 64; o <<= 1) v += __shfl_xor(v, o);
    return v;
}
__device__ __forceinline__ float fast_exp(float x) { return __builtin_amdgcn_exp2f(x * 1.4426950408889634f); }
__device__ __forceinline__ float sigmoidf_(float x) { return __builtin_amdgcn_rcpf(1.f + fast_exp(-x)); }
__device__ __forceinline__ float siluf_(float x) { return x * sigmoidf_(x); }
__device__ __forceinline__ float gelu_tanh(float x) {
    const float z = 0.7978845608028654f * (x + 0.044715f * x * x * x);
    const float t = 1.f - 2.f * __builtin_amdgcn_rcpf(1.f + fast_exp(2.f * z));
    return 0.5f * x * (1.f + t);
}
__device__ __forceinline__ void sincos_rev(float r, float& s, float& c) { r = r - rintf(r); s = __builtin_amdgcn_sinf(r); c = __builtin_amdgcn_cosf(r); }
__device__ __forceinline__ void sincos_rad(float a, float& s, float& c) { sincos_rev(a * 0.15915494309189535f, s, c); }
__device__ __forceinline__ void sincos_rad_d(double a, float& s, float& c) { double r = a * 0.15915494309189533577; r = r - __builtin_rint(r); s = __builtin_amdgcn_sinf((float)r); c = __builtin_amdgcn_cosf((float)r); }

__device__ __forceinline__ int lane_id() { int l; asm volatile("v_mbcnt_lo_u32_b32 %0, -1, 0\n\tv_mbcnt_hi_u32_b32 %0, -1, %0" : "=&v"(l)); return l; }

#define XB_TMO      128
#define XB_XCNT(j)  (256  + 64 * (j))
#define XB_XSUB(j)  (1280 + 64 * (j))
#define XB_XGEN(j)  (2304 + 64 * (j))
#define XB_TOP      3328
#define XB_TOPGEN   3392
#define XCD_BAR_WORDS 3456
#define XB_SPIN_CAP (1u << 18)
__device__ __forceinline__ unsigned xb_ld(unsigned* p)              { return __hip_atomic_load(p, __ATOMIC_RELAXED, __HIP_MEMORY_SCOPE_AGENT); }
__device__ __forceinline__ unsigned xb_add(unsigned* p, unsigned v) { return __hip_atomic_fetch_add(p, v, __ATOMIC_RELAXED, __HIP_MEMORY_SCOPE_AGENT); }
__device__ __forceinline__ unsigned xb_xcc_id() { return (unsigned)__builtin_amdgcn_s_getreg((3 << 11) | 20) & 0xFu; }
#define XB_SPIN(cond, bar) do { unsigned _sp = 0; while (cond) { __builtin_amdgcn_s_sleep(1); \
    if ((++_sp & 255u) == 0u) { if (xb_ld(&(bar)[XB_TMO])) break; if (_sp > XB_SPIN_CAP) { atomicAdd(&(bar)[XB_TMO], 1u); break; } } } } while (0)
struct XcdBarrier { unsigned* bar; unsigned x; volatile LAS unsigned* st; };
__device__ __forceinline__ XcdBarrier xcd_barrier_post(unsigned* bar, volatile LAS unsigned* st) {
    XcdBarrier b; b.bar = bar; b.x = xb_xcc_id(); b.st = st;
    if (threadIdx.x == 0) (void)xb_add(&bar[XB_XCNT(b.x)], 1u);
    return b;
}
__device__ __forceinline__ void xcd_barrier_complete(unsigned* bar, unsigned x, unsigned& nloc, unsigned& nx, const unsigned G) {
    unsigned sum, cnt, mine, sp = 0u;
    for (;;) {
        sum = 0u; cnt = 0u; mine = 0u;
#pragma unroll
        for (unsigned j = 0; j < 16; ++j) { const unsigned c = xb_ld(&bar[XB_XCNT(j)]); sum += c; cnt += (c > 0u) ? 1u : 0u; mine = (j == x) ? c : mine; }
        if (sum == G) break;
        __builtin_amdgcn_s_sleep(1);
        if ((++sp & 255u) == 0u) { if (xb_ld(&bar[XB_TMO])) break; if (sp > XB_SPIN_CAP) { atomicAdd(&bar[XB_TMO], 1u); break; } }
    }
    nloc = mine > 0u ? mine : 1u; nx = cnt > 0u ? cnt : 1u;
}
__device__ __noinline__ void xcd_barrier_f(unsigned* bar_, unsigned bx_, volatile LAS unsigned* st_, int tid_, unsigned G_) {
    XcdBarrier b; b.bar = bar_; b.x = bx_; b.st = st_;
    asm volatile("s_waitcnt vmcnt(0)" ::: "memory");
    __syncthreads();
    if (tid_ == 0) {
        unsigned* bar = b.bar;
        __builtin_amdgcn_s_waitcnt(0);
        unsigned nloc = b.st[0], nx = b.st[1];
        if (nloc == 0u) { xcd_barrier_complete(bar, b.x, nloc, nx, G_); b.st[0] = nloc; b.st[1] = nx; }
        const unsigned old = xb_add(&bar[XB_XSUB(b.x)], 1u);
        const unsigned gen = old / nloc;
        if (old + 1u == (gen + 1u) * nloc) {
            __builtin_amdgcn_fence(__ATOMIC_RELEASE, "agent");
            asm volatile("s_waitcnt vmcnt(0)" ::: "memory");
            const unsigned og = xb_add(&bar[XB_TOP], 1u);
            const unsigned tg = og / nx;
            if (og + 1u == (tg + 1u) * nx) xb_add(&bar[XB_TOPGEN], 1u);
            else XB_SPIN(xb_ld(&bar[XB_TOPGEN]) == tg, bar);
            __builtin_amdgcn_fence(__ATOMIC_ACQUIRE, "agent");
            xb_add(&bar[XB_XGEN(b.x)], 1u);
            asm volatile("s_waitcnt vmcnt(0)" ::: "memory");
        } else {
            XB_SPIN(xb_ld(&bar[XB_XGEN(b.x)]) == gen, bar);
            __builtin_amdgcn_fence(__ATOMIC_ACQUIRE, "agent");
            asm volatile("s_waitcnt vmcnt(0)" ::: "memory");
        }
    }
    __syncthreads();
}
__device__ __forceinline__ void xcd_barrier(const XcdBarrier& b, int tid, unsigned G) { xcd_barrier_f(b.bar, b.x, b.st, tid, G); }

namespace pg8 {
constexpr int BM = 256, BK = 64, HALF = 128, HTB = HALF * BK * 2, STAGE_BYTES = 8 * HTB;
__host__ __device__ __forceinline__ int lds_byte(int r, int c) { const int st = (r >> 4) * 2 + (c >> 5), rr = r & 15, cc = c & 31, ob = rr * 64 + cc * 2; return st * 1024 + (ob ^ (((ob >> 9) & 1) << 5)); }
__host__ __device__ __forceinline__ void stage_rc(int b, int& R, int& C) { const int st = b / 1024, sb = b % 1024, swz = sb ^ (((sb >> 9) & 1) << 5); R = (st >> 1) * 16 + swz / 64; C = (st & 1) * 32 + (swz % 64) / 2; }
__host__ __device__ __forceinline__ int perm32(int rho) { const int n = rho >> 4, i = rho & 15; return 8 * (i >> 2) + 4 * n + (i & 3); }

struct Unit { int pm, pn, arow, brow, aux, nval; };
struct Gemm { const bf16_t* A; const bf16_t* Bt; int lda, ldb, K; };

template <class Epi, class Sched, bool ALIGN_EPI = true, bool SP2 = true, bool GATHER = false>
__device__ __forceinline__ void gemm_phase(LAS unsigned char* lds, const Gemm g, const Sched& S, const Epi& E, int wave_, const int* rowidx = nullptr) {
    static_assert(SP2 || !GATHER, "GATHER is implemented for the SP2 loop only");
    int tid_ = wave_ * 64 + lane_id(); asm volatile("" : "+v"(tid_));
    const int tid = tid_, wid = __builtin_amdgcn_readfirstlane(tid >> 6), lane = tid & 63, wr = wid >> 2, wc = wid & 3, fr = lane & 15, fq = lane >> 4;
    int K_ = g.K; asm volatile("" : "+s"(K_));
    const int K = K_, nt = K / BK;
    unsigned voffA[2], voffB[2]; int sR[2]; unsigned sC2[2];
#pragma unroll
    for (int i = 0; i < 2; ++i) { int R, C; stage_rc(tid * 16 + i * 8192, R, C); const int Rb = Epi::PERM ? ((R & ~31) + perm32(R & 31)) : R; sR[i] = R; sC2[i] = (unsigned)C * 2u;
        voffA[i] = (unsigned)(R * g.lda + C) * 2u; voffB[i] = (unsigned)(Rb * g.ldb + C) * 2u; }
    const size_t kstep = (size_t)(BK * 2);
    const size_t hstepA = (size_t)HALF * g.lda * 2, hstepB = (size_t)HALF * g.ldb * 2;
    unsigned cvA0[2], cvA1[2], nvA0[2], nvA1[2];
#define PG8_AOFFS(dst0, dst1, un_) do { _Pragma("unroll") for (int _i = 0; _i < 2; ++_i) { \
        if constexpr (GATHER) { const int _r0 = sR[_i], _r1 = HALF + sR[_i];            \
            const int _c0 = (_r0 < (un_).nval) ? _r0 : (un_).nval - 1, _c1 = (_r1 < (un_).nval) ? _r1 : (un_).nval - 1;     \
            const unsigned _x0 = (unsigned)rowidx[(un_).arow + _c0], _x1 = (unsigned)rowidx[(un_).arow + _c1]; \
            dst0[_i] = _x0 * (unsigned)(g.lda * 2) + sC2[_i]; dst1[_i] = _x1 * (unsigned)(g.lda * 2) + sC2[_i]; } \
        else { dst0[_i] = voffA[_i]; dst1[_i] = voffA[_i] + (unsigned)hstepA; } } } while (0)
    const unsigned ldsw = (unsigned)wid * 1024u;
    const int aoff = lds_byte(wr * 64 + fr, fq * 8), boff = lds_byte(wc * 32 + fr, fq * 8);
#define PG8_SA(b, h) (((b) * 2 + (h)) * HTB)
#define PG8_SB(b, h) ((4 + (b) * 2 + (h)) * HTB)
#define PG8_STAGE(bufoff, gbase, voff) do { _Pragma("unroll") for (int _i = 0; _i < 2; ++_i) \
        __builtin_amdgcn_global_load_lds((const unsigned*)((const char*)(gbase) + (voff)[_i]), (LAS unsigned*)(lds + (bufoff) + ldsw + _i * 8192), 16, 0, 0); } while (0)
#define PG8_LDA(dst, b, h) do { _Pragma("unroll") for (int m = 0; m < 4; ++m) _Pragma("unroll") for (int k = 0; k < 2; ++k) dst[m][k] = *(const LAS bf16x8*)(lds + PG8_SA(b, h) + aoff + m * 2048 + k * 1024); } while (0)
#define PG8_LDB(dst, b, h) do { _Pragma("unroll") for (int n = 0; n < 2; ++n) _Pragma("unroll") for (int k = 0; k < 2; ++k) dst[n][k] = *(const LAS bf16x8*)(lds + PG8_SB(b, h) + boff + n * 2048 + k * 1024); } while (0)
#define PG8_MMA(ai, bj, At, Bt) do { __builtin_amdgcn_s_setprio(1); _Pragma("unroll") for (int m = 0; m < 4; ++m) _Pragma("unroll") for (int n = 0; n < 2; ++n) _Pragma("unroll") for (int k = 0; k < 2; ++k) \
        acc[ai][bj][m][n] = __builtin_amdgcn_mfma_f32_16x16x32_bf16(Bt[n][k], At[m][k], acc[ai][bj][m][n], 0, 0, 0); __builtin_amdgcn_s_setprio(0); } while (0)
#define PG8_WAIT_V(n) asm volatile("s_waitcnt vmcnt(" #n ")" ::: "memory")
#define PG8_WAIT_L(n) asm volatile("s_waitcnt lgkmcnt(" #n ")" ::: "memory")
#define PG8_BAR __builtin_amdgcn_s_barrier()
#define PG8_SCHED __builtin_amdgcn_sched_barrier(0)
    Unit cur, nxt; int ui = 0;
    if (!S.next(0, cur)) return;
    f32x4 acc[2][2][4][2];
#pragma unroll
    for (int a = 0; a < 2; ++a)
#pragma unroll
        for (int b = 0; b < 2; ++b)
#pragma unroll
            for (int m = 0; m < 4; ++m)
#pragma unroll
                for (int n = 0; n < 2; ++n) acc[a][b][m][n] = (f32x4){0.f, 0.f, 0.f, 0.f};
    bf16x8 At[4][2], B0[2][2], B1[2][2];
    const char* cA = GATHER ? (const char*)g.A : (const char*)g.A + (size_t)cur.arow * g.lda * 2; const char* cB = (const char*)g.Bt + (size_t)cur.brow * g.ldb * 2;
    PG8_AOFFS(cvA0, cvA1, cur);
    if constexpr (SP2) {
        PG8_STAGE(PG8_SB(0, 0), cB, voffB); PG8_STAGE(PG8_SB(0, 1), cB + hstepB, voffB); PG8_STAGE(PG8_SA(0, 0), cA, cvA0); PG8_STAGE(PG8_SA(0, 1), cA, cvA1);
        if (wr == 1) PG8_BAR;
        PG8_WAIT_V(2); PG8_BAR;
        PG8_STAGE(PG8_SB(1, 0), cB + kstep, voffB); PG8_STAGE(PG8_SA(1, 0), cA + kstep, cvA0); PG8_STAGE(PG8_SB(1, 1), cB + hstepB + kstep, voffB);
        PG8_WAIT_V(6); PG8_BAR;
    } else {
        PG8_STAGE(PG8_SB(0, 0), cB, voffB); PG8_STAGE(PG8_SA(0, 0), cA, voffA); PG8_STAGE(PG8_SB(0, 1), cB + hstepB, voffB); PG8_STAGE(PG8_SA(0, 1), cA + hstepA, voffA);
        if (wr == 1) PG8_BAR;
        PG8_WAIT_V(4); PG8_BAR;
        PG8_STAGE(PG8_SB(1, 0), cB + kstep, voffB); PG8_STAGE(PG8_SA(1, 0), cA + kstep, voffA); PG8_STAGE(PG8_SB(1, 1), cB + hstepB + kstep, voffB);
        PG8_WAIT_V(6); PG8_BAR;
    }
    for (;;) {
        const bool has_next = S.next(ui + 1, nxt);
        const char* nA = (has_next && !GATHER) ? (const char*)g.A + (size_t)nxt.arow * g.lda * 2 : cA; const char* nB = has_next ? (const char*)g.Bt + (size_t)nxt.brow * g.ldb * 2 : cB;
        if (GATHER && has_next) PG8_AOFFS(nvA0, nvA1, nxt);
        else { _Pragma("unroll") for (int _i = 0; _i < 2; ++_i) { nvA0[_i] = cvA0[_i]; nvA1[_i] = cvA1[_i]; } }
        for (int t = 0; t < nt; t += 2) {
            const bool last = (t == nt - 2);
            const char* a1 = cA + (size_t)(t + 1) * kstep;
            const char* a2 = last ? nA : cA + (size_t)(t + 2) * kstep; const char* b2 = last ? nB : cB + (size_t)(t + 2) * kstep;
            const char* a3 = a2 + kstep; const char* b3 = b2 + kstep;
            if constexpr (SP2) {
            unsigned xA0[2], xA1[2];
#pragma unroll
            for (int _i = 0; _i < 2; ++_i) { xA0[_i] = last ? nvA0[_i] : cvA0[_i]; xA1[_i] = last ? nvA1[_i] : cvA1[_i]; }
            PG8_LDB(B0, 0, 0); PG8_LDB(B1, 0, 1); PG8_SCHED; PG8_LDA(At, 0, 0); PG8_STAGE(PG8_SA(1, 1), a1, cvA1);
            PG8_WAIT_V(8); PG8_WAIT_L(0); PG8_BAR; PG8_MMA(0, 0, At, B0); PG8_MMA(0, 1, At, B1); PG8_BAR; PG8_SCHED;
            PG8_LDA(At, 0, 1); PG8_STAGE(PG8_SB(0, 0), b2, voffB); PG8_STAGE(PG8_SB(0, 1), b2 + hstepB, voffB); PG8_STAGE(PG8_SA(0, 0), a2, xA0);
            PG8_WAIT_V(8); PG8_WAIT_L(0); PG8_BAR; PG8_MMA(1, 0, At, B0); PG8_MMA(1, 1, At, B1); PG8_BAR; PG8_SCHED;
            PG8_LDB(B0, 1, 0); PG8_LDB(B1, 1, 1); PG8_SCHED; PG8_LDA(At, 1, 0); PG8_STAGE(PG8_SA(0, 1), a2, xA1);
            PG8_WAIT_V(8); PG8_WAIT_L(0); PG8_BAR; PG8_MMA(0, 0, At, B0); PG8_MMA(0, 1, At, B1); PG8_BAR; PG8_SCHED;
            PG8_LDA(At, 1, 1); PG8_STAGE(PG8_SB(1, 0), b3, voffB); PG8_STAGE(PG8_SB(1, 1), b3 + hstepB, voffB); PG8_STAGE(PG8_SA(1, 0), a3, xA0);
            PG8_WAIT_V(8); PG8_WAIT_L(0); PG8_BAR; PG8_MMA(1, 0, At, B0); PG8_MMA(1, 1, At, B1); PG8_BAR; PG8_SCHED;
            } else {
            PG8_LDB(B0, 0, 0); PG8_SCHED; PG8_LDA(At, 0, 0); PG8_STAGE(PG8_SA(1, 1), a1 + hstepA, voffA);
            PG8_WAIT_L(8); PG8_BAR; PG8_WAIT_L(0); PG8_MMA(0, 0, At, B0); PG8_BAR; PG8_SCHED;
            PG8_LDB(B1, 0, 1); PG8_STAGE(PG8_SB(0, 0), b2, voffB);
            PG8_BAR; PG8_WAIT_L(0); PG8_MMA(0, 1, At, B1); PG8_BAR;
            PG8_LDA(At, 0, 1); PG8_STAGE(PG8_SA(0, 0), a2, voffA);
            PG8_BAR; PG8_WAIT_L(0); PG8_MMA(1, 0, At, B0); PG8_BAR; PG8_SCHED;
            PG8_STAGE(PG8_SB(0, 1), b2 + hstepB, voffB);
            PG8_WAIT_V(6); PG8_BAR; PG8_MMA(1, 1, At, B1); PG8_BAR;
            PG8_LDB(B0, 1, 0); PG8_SCHED; PG8_LDA(At, 1, 0); PG8_STAGE(PG8_SA(0, 1), a2 + hstepA, voffA);
            PG8_WAIT_L(8); PG8_BAR; PG8_WAIT_L(0); PG8_MMA(0, 0, At, B0); PG8_BAR; PG8_SCHED;
            PG8_LDB(B1, 1, 1); PG8_STAGE(PG8_SB(1, 0), b3, voffB);
            PG8_BAR; PG8_WAIT_L(0); PG8_MMA(0, 1, At, B1); PG8_BAR;
            PG8_LDA(At, 1, 1); PG8_STAGE(PG8_SA(1, 0), a3, voffA);
            PG8_BAR; PG8_WAIT_L(0); PG8_MMA(1, 0, At, B0); PG8_BAR; PG8_SCHED;
            PG8_STAGE(PG8_SB(1, 1), b3 + hstepB, voffB);
            PG8_WAIT_V(6); PG8_BAR; PG8_MMA(1, 1, At, B1); PG8_BAR;
            }
        }
        if constexpr (ALIGN_EPI) { if (wr == 0) PG8_BAR; }
        E(acc, cur, wr, wc, fr, fq);
        if (!has_next) break;
        float zf = 0.f; asm volatile("" : "+v"(zf));
#pragma unroll
        for (int a = 0; a < 2; ++a)
#pragma unroll
            for (int b = 0; b < 2; ++b)
#pragma unroll
                for (int m = 0; m < 4; ++m)
#pragma unroll
                    for (int n = 0; n < 2; ++n) acc[a][b][m][n] = (f32x4){zf, zf, zf, zf};
        cur = nxt; cA = nA; cB = nB; ++ui;
#pragma unroll
        for (int _i = 0; _i < 2; ++_i) { cvA0[_i] = nvA0[_i]; cvA1[_i] = nvA1[_i]; }
        if constexpr (ALIGN_EPI) { if (wr == 1) PG8_BAR; }
    }
    PG8_WAIT_V(0);
    if constexpr (!ALIGN_EPI) { if (wr == 0) PG8_BAR; }
    PG8_BAR;
#undef PG8_SA
#undef PG8_AOFFS
#undef PG8_SB
#undef PG8_STAGE
#undef PG8_LDA
#undef PG8_LDB
#undef PG8_MMA
#undef PG8_WAIT_V
#undef PG8_WAIT_L
#undef PG8_BAR
#undef PG8_SCHED
}
}

constexpr size_t al256(size_t x) { return (x + 255) & ~(size_t)255; }
constexpr size_t WS_CTL = 0;
constexpr size_t WS_MOD = 1u << 20;
constexpr size_t ZERO_BYTES = 2u << 20;
constexpr size_t WS_XL   = ZERO_BYTES;
constexpr size_t WS_ACT  = WS_XL + (size_t)TT * DM * 4;
constexpr size_t WS_SSQP = WS_ACT + (size_t)TT * DM * 2;
constexpr size_t WS_EID  = WS_SSQP + (size_t)TT * 32 * 4;
constexpr size_t WS_GATE = WS_EID + (size_t)TT * 8;
constexpr size_t WS_SLOT = WS_GATE + (size_t)TT * 8;
constexpr size_t WS_HIST = WS_SLOT + (size_t)TT * 8;
constexpr size_t WS_BLKE = WS_HIST + 256 * 32 * 4;
constexpr size_t WS_ROPE = WS_BLKE + 512 * 4;
constexpr int MOE_CAP = TT * 2;
constexpr size_t WS_RTOK = al256(WS_ROPE + 64 * 8 * 2 * 4);
constexpr size_t WS_MIX  = al256(WS_RTOK + (size_t)NEXP * MOE_CAP * 4);
constexpr int CW_ECNT = 200000;
constexpr size_t WS_P    = WS_MIX;
constexpr size_t WS_Q    = WS_P + (size_t)TT * PW * 2;
constexpr size_t WS_KV   = WS_Q + (size_t)TT * QW * 2;
constexpr size_t WS_KR   = WS_KV + (size_t)TT * KVW * 2;
constexpr size_t WS_UA   = WS_KR + (size_t)TT * 32 * 2;
constexpr size_t WS_S5S  = WS_UA + (size_t)S5G * S5ROWSP * S5K * 2;
constexpr size_t WS_Y1   = WS_S5S + (size_t)S5G * S5ROWSP * 256 * 4;
constexpr size_t WS_S5O  = WS_Y1 + (size_t)TT * 256 * 2;
constexpr size_t WS_MLAO = WS_S5O + (size_t)TT * 256 * 2;
constexpr size_t WS_HYT  = WS_MLAO + (size_t)TT * 512 * 2;
constexpr size_t WS_HYTC = WS_HYT + (size_t)3 * NB * HYW * SEQ * 2;
constexpr size_t WS_HYO  = WS_HYTC + (size_t)3 * NB * HYW * CTXL * 2;
constexpr size_t WS_HYOC = WS_HYO + (size_t)NB * HYW * SEQ * 2;
constexpr size_t WS_MIXEND = WS_HYOC + (size_t)NB * HYW * CTXL * 2;
constexpr size_t WS_GX   = WS_MIX;
constexpr size_t WS_HID  = WS_GX + (size_t)MOE_MAXROWS * DM * 2;
static_assert(WS_HID + (size_t)MOE_MAXROWS * MOEH * 2 <= WS_MIXEND, "MoE overlay fits");
constexpr size_t WS_WIN  = al256(WS_MIXEND);
constexpr size_t WS_WUQ  = WS_WIN + (size_t)PW * DM * 2;
constexpr size_t WS_WUKV = WS_WUQ + (size_t)QW * 384 * 2;
constexpr size_t WS_WOUT = WS_WUKV + (size_t)KVW * 256 * 2;
constexpr size_t WS_GLUW = WS_WOUT + (size_t)DM * DM * 2;
constexpr size_t WS_W13  = WS_GLUW + (size_t)256 * 256 * 2;
constexpr size_t WS_W2T  = WS_W13 + (size_t)NEXP * 1024 * DM * 2;
constexpr size_t WS_TMV  = WS_W2T + (size_t)NEXP * DM * MOEH * 2;
constexpr size_t WS_WMT  = WS_TMV + (size_t)S5G * 1024 * S5K * 2;
constexpr size_t WS_LAML = WS_WMT + (size_t)S5G * 256 * 1024 * 2;
constexpr size_t WS_KTAB = WS_LAML + (size_t)2 * S5G * S5P * 2 * 4;
constexpr size_t WS_FILT = WS_KTAB + (size_t)2 * S5G * S5LC * 256 * 4;
constexpr size_t WS_FILTC= WS_FILT + (size_t)2 * HYW * HYN2 * 4;
constexpr size_t WS_SPEC = WS_FILTC + (size_t)2 * 2 * HYW * CTXL * 4;
constexpr size_t WS_MODAB = WS_SPEC + (size_t)2 * HYW * HYN2 * 8;
constexpr size_t WS_END  = WS_MODAB + (size_t)NLAYER * 9 * 4 * DM * 4;
constexpr int CW_BAR = 4096;

constexpr int LDS_BYTES = 156672;
constexpr int LDS_MISC = 155648;

struct Args { const float* in[40]; float* out; unsigned char* ws; int ph_lo, ph_hi, li, pad; };
enum { I_X = 0, I_C, I_CTX, I_CCTX, I_ADAW, I_ADAB, I_N1G, I_N2G, I_WIN, I_LRE, I_LIM, I_LDT, I_BRE, I_BIM, I_CRE, I_CIM, I_S5D, I_GLU, I_QNG, I_KVNG, I_WUQ, I_WUKV,
       I_HSW, I_HSB, I_FW1, I_FB1, I_FW2, I_FB2, I_FW3, I_FB3, I_FFQ, I_HBIAS, I_MIXG, I_WOUT, I_WGRP, I_WEXP, I_W1, I_W3, I_W2, I_FING };

struct Ctx {
    const Args* a; unsigned char* ws; LAS unsigned char* lds;
    int tid, lane, wave, vcu, G, gw, ngw, z;
};
__device__ __forceinline__ Ctx fresh(const Ctx& X) { Ctx Y = X; { GAS unsigned char* gp = (GAS unsigned char*)X.ws; asm volatile("" : "+s"(gp)); Y.ws = (unsigned char*)gp; }
    int w = Y.wave; asm volatile("" : "+s"(w)); Y.wave = w; Y.lane = lane_id(); asm volatile("" : "+v"(Y.lane)); Y.tid = w * 64 + Y.lane; int v = Y.vcu; asm volatile("" : "+s"(v)); Y.vcu = v; Y.gw = v * NWAVES + w; int z = 0; asm volatile("" : "+s"(z)); Y.z = z; return Y; }
__device__ __forceinline__ int row_b(int row) { return row < TL ? (row >> 12) : 8; }

struct SchedRM {
    int nN, total, G, c, off;
    __device__ __forceinline__ bool next(int i, pg8::Unit& u) const {
        const int L = i * G + ((c + G - off) % G); if (L >= total) return false;
        u.pm = L / nN; u.pn = L % nN; u.arow = u.pm * 256; u.brow = u.pn * 256; u.aux = 0; u.nval = 256; return true; }
};
struct SchedRMW {
    int nN, total, W, cw, l0;
    __device__ __forceinline__ bool next(int i, pg8::Unit& u) const {
        const int L = l0 + i * W + cw; if (cw < 0 || L >= total) return false;
        u.pm = L / nN; u.pn = L % nN; u.arow = u.pm * 256; u.brow = u.pn * 256; u.aux = 0; u.nval = 256; return true; }
};
struct SchedS5 {
    int nN, total, G, c, off, ldbrows;
    __device__ __forceinline__ bool next(int i, pg8::Unit& u) const {
        const int L = i * G + ((c + G - off) % G); if (L >= total) return false;
        const int g = L / (3 * nN), r = L % (3 * nN); u.pm = r / nN; u.pn = r % nN; u.aux = g;
        u.arow = g * S5ROWSP + u.pm * 256; u.brow = g * ldbrows + u.pn * 256; u.nval = 256; return true; }
};
constexpr int MT_OFF = LDS_MISC + 256;
struct SchedMoE {
    const LAS int* mt; int G, c; bool gather;
    __device__ __forceinline__ bool next(int i, pg8::Unit& u) const {
        const int L = i * G + c, tile = L >> 2; if (tile >= mt[32 + 32]) return false;
        int e = 0;
        for (int k = 1; k < NEXP; ++k) e = (tile >= mt[32 + k]) ? k : e;
        const int t0 = tile - mt[32 + e];
        u.pm = tile; u.pn = L & 3; u.aux = e; u.brow = e * 1024 + u.pn * 256;
        u.nval = mt[e] - t0 * 256; u.arow = gather ? e * MOE_CAP + t0 * 256 : tile * 256; return true; }
};

typedef f32x4 AccT[2][2][4][2];
__device__ __forceinline__ u32x4 pack8(const f32x4 a, const f32x4 b) { u32x4 w; w.x = cvt_pk_bf16(a[0], a[1]); w.y = cvt_pk_bf16(a[2], a[3]); w.z = cvt_pk_bf16(b[0], b[1]); w.w = cvt_pk_bf16(b[2], b[3]); return w; }

struct EpiP {
    static constexpr bool PERM = true;
    bf16_t* P; bf16_t* UA; float* SSQP;
    __device__ __forceinline__ void operator()(const AccT& acc, const pg8::Unit& u, int wr, int wc, int fr, int fq) const {
#pragma unroll
        for (int ai = 0; ai < 2; ++ai)
#pragma unroll
            for (int m = 0; m < 4; ++m) {
                const int row = u.pm * 256 + ai * 128 + wr * 64 + m * 16 + fr;
                if (u.pn == 0) {
                    int R, s;
                    if (row < TL) { const int b = row >> 12, tt = row & 4095; R = b * S5NCH + 4 + (tt >> 6); s = tt & 63; }
                    else { const int rc = row - TL, b = rc >> 8, tt = rc & 255; R = b * S5NCH + (tt >> 6); s = tt & 63; }
#pragma unroll
                    for (int bj = 0; bj < 2; ++bj) { const int col = bj * 128 + wc * 32 + 8 * fq, g = col >> 4, h0 = col & 15;
                        *(u32x4*)(UA + ((size_t)(g * S5ROWSP + R) * S5K + s * 16 + h0)) = pack8(acc[ai][bj][m][0], acc[ai][bj][m][1]); }
                } else {
#pragma unroll
                    for (int bj = 0; bj < 2; ++bj) { const int col = u.pn * 256 + bj * 128 + wc * 32 + 8 * fq;
                        *(u32x4*)(P + (size_t)row * PW + col) = pack8(acc[ai][bj][m][0], acc[ai][bj][m][1]);
                        if (u.pn <= 3) {
                            const f32x4 a = acc[ai][bj][m][0], b = acc[ai][bj][m][1];
                            float s = (a[0] * a[0] + a[1] * a[1]) + (a[2] * a[2] + a[3] * a[3]) + (b[0] * b[0] + b[1] * b[1]) + (b[2] * b[2] + b[3] * b[3]);
                            s += __shfl_xor(s, 16); s += __shfl_xor(s, 32);
                            if (fq == 0) SSQP[(size_t)row * 32 + (u.pn - 1) * 8 + bj * 4 + wc] = s;
                        } }
                }
            }
    }
};
struct EpiS5A {
    static constexpr bool PERM = false;
    float* S;
    __device__ __forceinline__ void operator()(const AccT& acc, const pg8::Unit& u, int wr, int wc, int fr, int fq) const {
#pragma unroll
        for (int ai = 0; ai < 2; ++ai)
#pragma unroll
            for (int m = 0; m < 4; ++m) { const int R = u.pm * 256 + ai * 128 + wr * 64 + m * 16 + fr; float* rp = S + (size_t)(u.aux * S5ROWSP + R) * 256;
#pragma unroll
                for (int bj = 0; bj < 2; ++bj)
#pragma unroll
                    for (int n = 0; n < 2; ++n) *(f32x4*)(rp + bj * 128 + wc * 32 + n * 16 + 4 * fq) = acc[ai][bj][m][n]; }
    }
};
struct EpiQ {
    static constexpr bool PERM = true;
    bf16_t* Q; const float* SSQP; const LAS float* ROPE;
    __device__ __forceinline__ void operator()(const AccT& acc, const pg8::Unit& u, int wr, int wc, int fr, int fq) const {
        const bool latent = (u.pm * 256) < TL;
#pragma unroll
        for (int ai = 0; ai < 2; ++ai) {
            f32x4 sv[4][3];
#pragma unroll
            for (int m = 0; m < 4; ++m) { const f32x4* sp = (const f32x4*)(SSQP + (size_t)(u.pm * 256 + ai * 128 + wr * 64 + m * 16 + fr) * 32); sv[m][0] = sp[0]; sv[m][1] = sp[1]; sv[m][2] = sp[2]; }
            asm volatile("" ::: "memory");
#pragma unroll
            for (int m = 0; m < 4; ++m) {
                const int row = u.pm * 256 + ai * 128 + wr * 64 + m * 16 + fr;
                const f32x4 s0 = sv[m][0], s1 = sv[m][1], s2 = sv[m][2];
                const float ss = ((s0[0] + s0[1]) + (s0[2] + s0[3])) + ((s1[0] + s1[1]) + (s1[2] + s1[3])) + ((s2[0] + s2[1]) + (s2[2] + s2[3]));
                const float rstd = __builtin_amdgcn_rsqf(ss * (1.f / 384.f) + EPS);
                const int tt = row & 4095, pos = (fq < 2) ? (tt >> 6) : (tt & 63);
#pragma unroll
                for (int bj = 0; bj < 2; ++bj) {
                    const int col = u.pn * 256 + bj * 128 + wc * 32 + 8 * fq;
                    f32x4 v0 = acc[ai][bj][m][0] * rstd, v1 = acc[ai][bj][m][1] * rstd;
                    const bool rope = latent && (((col >> 5) % 3) == 2);
                    if (rope) {
                        const LAS f32x4* rp = (const LAS f32x4*)(ROPE + pos * 16);
                        const f32x4 t0 = rp[0], t1 = rp[1], t2 = rp[2], t3 = rp[3];
                        const float cs[8] = {t0[0], t0[2], t1[0], t1[2], t2[0], t2[2], t3[0], t3[2]};
                        const float sn[8] = {t0[1], t0[3], t1[1], t1[3], t2[1], t2[3], t3[1], t3[3]};
                        float v[8] = {v0[0], v0[1], v0[2], v0[3], v1[0], v1[1], v1[2], v1[3]};
#pragma unroll
                        for (int i = 0; i < 8; ++i) { const float pr = __shfl_xor(v[i], 16);
                            v[i] = (fq & 1) ? (pr * sn[i] + v[i] * cs[i]) : (v[i] * cs[i] - pr * sn[i]); }
                        v0 = (f32x4){v[0], v[1], v[2], v[3]}; v1 = (f32x4){v[4], v[5], v[6], v[7]};
                    }
                    *(u32x4*)(Q + (size_t)row * QW + col) = pack8(v0 * 0.14724523f, v1 * 0.14724523f);
                }
            }
            asm volatile("" ::: "memory");
        }
    }
};
struct EpiKV {
    static constexpr bool PERM = true;
    bf16_t* KV; const float* SSQP;
    __device__ __forceinline__ void operator()(const AccT& acc, const pg8::Unit& u, int wr, int wc, int fr, int fq) const {
        f32x4 sv[8][2];
#pragma unroll
        for (int ai = 0; ai < 2; ++ai)
#pragma unroll
            for (int m = 0; m < 4; ++m) { const f32x4* sp = (const f32x4*)(SSQP + (size_t)(u.pm * 256 + ai * 128 + wr * 64 + m * 16 + fr) * 32 + 12); sv[ai * 4 + m][0] = sp[0]; sv[ai * 4 + m][1] = sp[1]; }
        asm volatile("" ::: "memory");
#pragma unroll
        for (int ai = 0; ai < 2; ++ai)
#pragma unroll
            for (int m = 0; m < 4; ++m) {
                const int row = u.pm * 256 + ai * 128 + wr * 64 + m * 16 + fr;
                const f32x4 s0 = sv[ai * 4 + m][0], s1 = sv[ai * 4 + m][1];
                const float ss = ((s0[0] + s0[1]) + (s0[2] + s0[3])) + ((s1[0] + s1[1]) + (s1[2] + s1[3]));
                const float rstd = __builtin_amdgcn_rsqf(ss * (1.f / 256.f) + EPS);
#pragma unroll
                for (int bj = 0; bj < 2; ++bj) { const int col = u.pn * 256 + bj * 128 + wc * 32 + 8 * fq;
                    *(u32x4*)(KV + (size_t)row * KVW + col) = pack8(acc[ai][bj][m][0] * rstd, acc[ai][bj][m][1] * rstd); }
            }
        asm volatile("" ::: "memory");
    }
};
struct EpiS5C {
    static constexpr bool PERM = true;
    bf16_t* Y1;
    __device__ __forceinline__ void operator()(const AccT& acc, const pg8::Unit& u, int wr, int wc, int fr, int fq) const {
#pragma unroll
        for (int ai = 0; ai < 2; ++ai)
#pragma unroll
            for (int m = 0; m < 4; ++m) {
                const int R = u.pm * 256 + ai * 128 + wr * 64 + m * 16 + fr;
                if (R < S5ROWS) {
                    const int b = R / S5NCH, ch = R % S5NCH;
                    const int tok0 = (ch < 4) ? (TL + b * CTXL + ch * 64) : (b * SEQ + (ch - 4) * 64);
#pragma unroll
                    for (int bj = 0; bj < 2; ++bj) { const int col = u.pn * 256 + bj * 128 + wc * 32 + 8 * fq, tp = col >> 4, h0 = col & 15;
                        f32x4 a = acc[ai][bj][m][0], c = acc[ai][bj][m][1];
#pragma unroll
                        for (int i = 0; i < 4; ++i) { a[i] = gelu_tanh(a[i]); c[i] = gelu_tanh(c[i]); }
                        *(u32x4*)(Y1 + (size_t)(tok0 + tp) * 256 + u.aux * 16 + h0) = pack8(a, c); }
                }
            }
    }
};
struct EpiGLU {
    static constexpr bool PERM = true;
    const bf16_t* Y1; bf16_t* O;
    __device__ __forceinline__ void operator()(const AccT& acc, const pg8::Unit& u, int wr, int wc, int fr, int fq) const {
#pragma unroll
        for (int ai = 0; ai < 2; ++ai) {
            u32x4 yv[4][2];
#pragma unroll
            for (int m = 0; m < 4; ++m)
#pragma unroll
                for (int bj = 0; bj < 2; ++bj) yv[m][bj] = *(const u32x4*)(Y1 + (size_t)(u.pm * 256 + ai * 128 + wr * 64 + m * 16 + fr) * 256 + bj * 128 + wc * 32 + 8 * fq);
            asm volatile("" ::: "memory");
#pragma unroll
            for (int m = 0; m < 4; ++m) {
                const int row = u.pm * 256 + ai * 128 + wr * 64 + m * 16 + fr;
#pragma unroll
                for (int bj = 0; bj < 2; ++bj) { const int col = bj * 128 + wc * 32 + 8 * fq;
                    const u32x4 y = yv[m][bj];
                    const f32x4 a = acc[ai][bj][m][0], c = acc[ai][bj][m][1];
                    f32x4 o0, o1;
                    o0[0] = bflo(y.x) * sigmoidf_(a[0]); o0[1] = bfhi(y.x) * sigmoidf_(a[1]); o0[2] = bflo(y.y) * sigmoidf_(a[2]); o0[3] = bfhi(y.y) * sigmoidf_(a[3]);
                    o1[0] = bflo(y.z) * sigmoidf_(c[0]); o1[1] = bfhi(y.z) * sigmoidf_(c[1]); o1[2] = bflo(y.w) * sigmoidf_(c[2]); o1[3] = bfhi(y.w) * sigmoidf_(c[3]);
                    *(u32x4*)(O + (size_t)row * 256 + col) = pack8(o0, o1); }
            }
            asm volatile("" ::: "memory");
        }
    }
};
struct EpiOut {
    static constexpr bool PERM = false;
    float* XL; const float* MODL; float* SSQ;
    const float* RS0; const float* RS1;
    __device__ __forceinline__ void operator()(const AccT& acc, const pg8::Unit& u, int wr, int wc, int fr, int fq) const {
        const int rb = row_b(u.pm * 256);
        const float* mp = MODL + (size_t)rb * 6144 + 2 * DM + u.pn * 256;
        const float* rs = (u.pm * 256 < TL) ? RS0 : RS1;
        float sq[2][4];
#pragma unroll
        for (int ai = 0; ai < 2; ++ai)
#pragma unroll
            for (int m = 0; m < 4; ++m) sq[ai][m] = 0.f;
#pragma unroll
        for (int bj = 0; bj < 2; ++bj)
#pragma unroll
            for (int n = 0; n < 2; ++n) { const int c = bj * 128 + wc * 32 + n * 16 + 4 * fq; const f32x4 g = *(const f32x4*)(mp + c);
                f32x4 t[8];
#pragma unroll
                for (int ai = 0; ai < 2; ++ai)
#pragma unroll
                    for (int m = 0; m < 4; ++m) { const int row = u.pm * 256 + ai * 128 + wr * 64 + m * 16 + fr; t[ai * 4 + m] = *(const f32x4*)(rs + (size_t)row * DM + u.pn * 256 + c); }
                asm volatile("" ::: "memory");
#pragma unroll
                for (int ai = 0; ai < 2; ++ai)
#pragma unroll
                    for (int m = 0; m < 4; ++m) { const int row = u.pm * 256 + ai * 128 + wr * 64 + m * 16 + fr;
                        const f32x4 v = t[ai * 4 + m] + g * acc[ai][bj][m][n]; *(f32x4*)(XL + (size_t)row * DM + u.pn * 256 + c) = v;
                        sq[ai][m] += (v[0] * v[0] + v[1] * v[1]) + (v[2] * v[2] + v[3] * v[3]); } }
#pragma unroll
        for (int ai = 0; ai < 2; ++ai)
#pragma unroll
            for (int m = 0; m < 4; ++m) { float s = sq[ai][m]; s += __shfl_xor(s, 16); s += __shfl_xor(s, 32);
                if (fq == 0) SSQ[(size_t)(u.pm * 256 + ai * 128 + wr * 64 + m * 16 + fr) * 32 + u.pn * 4 + wc] = s; }
    }
};
struct EpiUp {
    static constexpr bool PERM = true;
    bf16_t* HID;
    __device__ __forceinline__ void operator()(const AccT& acc, const pg8::Unit& u, int wr, int wc, int fr, int fq) const {
#pragma unroll
        for (int ai = 0; ai < 2; ++ai)
#pragma unroll
            for (int m = 0; m < 4; ++m) { const int row = u.pm * 256 + ai * 128 + wr * 64 + m * 16 + fr;
                f32x4 h0, h1;
#pragma unroll
                for (int i = 0; i < 4; ++i) { h0[i] = siluf_(acc[ai][0][m][0][i]) * acc[ai][1][m][0][i]; h1[i] = siluf_(acc[ai][0][m][1][i]) * acc[ai][1][m][1][i]; }
                *(u32x4*)(HID + (size_t)row * MOEH + u.pn * 128 + wc * 32 + 8 * fq) = pack8(h0, h1); }
    }
};
struct EpiDown {
    static constexpr bool PERM = true;
    bf16_t* YS;
    __device__ __forceinline__ void operator()(const AccT& acc, const pg8::Unit& u, int wr, int wc, int fr, int fq) const {
#pragma unroll
        for (int ai = 0; ai < 2; ++ai)
#pragma unroll
            for (int m = 0; m < 4; ++m) { const int row = u.pm * 256 + ai * 128 + wr * 64 + m * 16 + fr;
#pragma unroll
                for (int bj = 0; bj < 2; ++bj) *(u32x4*)(YS + (size_t)row * DM + u.pn * 256 + bj * 128 + wc * 32 + 8 * fq) = pack8(acc[ai][bj][m][0], acc[ai][bj][m][1]); }
    }
};

namespace fft {
constexpr int N = 8192;
constexpr int LDS_FFT_BYTES = (N + N / 16 + 16) * 8;
__device__ __forceinline__ int PI(int i) { return i + (i >> 4); }
__device__ constexpr float C32[16] = {1.f, 0.98078528040323043f, 0.92387953251128674f, 0.83146961230254524f, 0.70710678118654752f, 0.55557023301960218f, 0.38268343236508977f, 0.19509032201612825f,
                                      0.f, -0.19509032201612825f, -0.38268343236508977f, -0.55557023301960218f, -0.70710678118654752f, -0.83146961230254524f, -0.92387953251128674f, -0.98078528040323043f};
__device__ constexpr float S32[16] = {0.f, 0.19509032201612825f, 0.38268343236508977f, 0.55557023301960218f, 0.70710678118654752f, 0.83146961230254524f, 0.92387953251128674f, 0.98078528040323043f,
                                      1.f, 0.98078528040323043f, 0.92387953251128674f, 0.83146961230254524f, 0.70710678118654752f, 0.55557023301960218f, 0.38268343236508977f, 0.19509032201612825f};
__host__ __device__ constexpr int bitrev(int i, int bits) { int r = 0; for (int b = 0; b < bits; ++b) r |= ((i >> b) & 1) << (bits - 1 - b); return r; }
__host__ __device__ constexpr int ilog2(int n) { int b = 0; while ((1 << b) < n) ++b; return b; }

template <int R, int START = R> __device__ __forceinline__ void dft_inreg(f32x2 (&v)[R]) {
#pragma unroll
    for (int len = START; len >= 2; len >>= 1) {
        const int half = len / 2;
#pragma unroll
        for (int base = 0; base < R; base += len)
#pragma unroll
            for (int k = 0; k < half; ++k) {
                const f32x2 a = v[base + k], b = v[base + k + half];
                v[base + k] = a + b;
                const f32x2 t = a - b;
                const int ti = k * (32 / len);
                if (ti == 0) v[base + k + half] = t;
                else if (ti == 8) v[base + k + half] = (f32x2){t.y, -t.x};
                else { const float c = C32[ti], s = S32[ti]; v[base + k + half] = (f32x2){t.x * c + t.y * s, t.y * c - t.x * s}; }
            }
    }
}
template <int R> __device__ __forceinline__ void pass(LAS f32x2* buf, int Ns, int tid) {
    constexpr int T = N / R, NBF = (T + NTHR - 1) / NTHR, BITS = ilog2(R);
    static_assert(NBF == 1, "one butterfly per thread at most");
    f32x2 v[R];
    int j_ = tid; asm volatile("" : "+v"(j_));
    const int j = j_; const bool act = j < T;
    const int k = j & (Ns - 1);
    if (act) {
        const LAS f32x2* sp = buf + PI(j);
#pragma unroll
        for (int r = 0; r < R; ++r) v[r] = sp[r * (T + T / 16)];
        if (Ns > 1) {
            const float base = -(float)k / (float)(Ns * R);
#pragma unroll
            for (int r = 1; r < R; ++r) { float s, c; sincos_rev(base * (float)r, s, c); const f32x2 x = v[r]; v[r] = (f32x2){x.x * c - x.y * s, x.x * s + x.y * c}; }
        }
        dft_inreg<R>(v);
    }
    __syncthreads();
    if (act) {
        const int j0 = (j - k) * R + k;
#pragma unroll
        for (int q = 0; q < R; ++q) buf[PI(j0 + q * Ns)] = v[bitrev(q, BITS)];
    }
    __syncthreads();
}
__device__ __forceinline__ void pass2_last(LAS f32x2* buf, int tid) {
    asm volatile("" : "+v"(tid));
#pragma unroll
    for (int i = 0; i < 8; ++i) { const int j = tid + NTHR * i;
        const f32x2 a = buf[PI(j)], b = buf[PI(j + 4096)];
        float s, c; sincos_rev(-(float)j * (1.f / 8192.f), s, c);
        const f32x2 bw = {b.x * c - b.y * s, b.x * s + b.y * c};
        buf[PI(j)] = a + bw; buf[PI(j + 4096)] = a - bw; }
    __syncthreads();
}
constexpr int TW_FLOATS2 = 256 + 4096 + 4096;
__device__ __forceinline__ void build_tables(LAS f32x2* tw, int tid) {
    for (int i = tid; i < TW_FLOATS2; i += NTHR) {
        float rev;
        if (i < 256) { const int r = i >> 4, k = i & 15; rev = -(float)(r * k) * (1.f / 256.f); }
        else if (i < 256 + 4096) { const int q = i - 256, r = q >> 8, k = q & 255; rev = -(float)(r * k) * (1.f / 4096.f); }
        else rev = -(float)(i - 4352) * (1.f / 8192.f);
        float s, c; sincos_rev(rev, s, c); tw[i] = (f32x2){c, s};
    }
}
template <int NS> __device__ __forceinline__ void pass16_tab(LAS f32x2* buf, const LAS f32x2* tw, int tid) {
    constexpr int R = 16, T = N / R;
    f32x2 v[R];
    int j_ = tid; asm volatile("" : "+v"(j_));
    const int j = j_, k = j & (NS - 1);
#pragma unroll
    for (int r = 0; r < R; ++r) v[r] = buf[PI(j + r * T)];
    if (NS > 1) {
        const LAS f32x2* t = (NS == 16) ? (tw + k) : (tw + 256 + k);
#pragma unroll
        for (int r = 1; r < R; ++r) { const f32x2 w = t[r * NS]; const f32x2 x = v[r]; v[r] = (f32x2){x.x * w.x - x.y * w.y, x.x * w.y + x.y * w.x}; }
    }
    dft_inreg<R>(v);
    __syncthreads();
    const int j0 = (j - k) * R + k;
#pragma unroll
    for (int q = 0; q < R; ++q) buf[PI(j0 + q * NS)] = v[bitrev(q, 4)];
    __syncthreads();
}
__device__ __forceinline__ void build_tw2(LAS f32x2* tw, int tid) {
    if (tid < 256) { const int r = tid >> 4, k = tid & 15; float s, c; sincos_rev(-(float)(r * k) * (1.f / 256.f), s, c); tw[tid] = (f32x2){c, s}; }
}
template <int NS, bool ZHI = false> __device__ __forceinline__ void pass16_pp(const LAS f32x2* src, LAS f32x2* dst, const LAS f32x2* tw2, const f32x2 tw31, int tid) {
    static_assert(!ZHI || NS == 1, "ZHI (elements 4096.. are zero and not stored) is the first pass only");
    constexpr int R = 16, T = N / R;
    f32x2 v[R];
    int j_ = tid; asm volatile("" : "+v"(j_));
    const int j = j_, k = j & (NS - 1);
    const LAS f32x2* sp = src + PI(j);
#pragma unroll
    for (int r = 0; r < (ZHI ? R / 2 : R); ++r) v[r] = sp[r * (T + T / 16)];
    if (NS == 16) { const LAS f32x2* t = tw2 + k;
#pragma unroll
        for (int r = 1; r < R; ++r) { const f32x2 w = t[r * 16]; const f32x2 x = v[r]; v[r] = (f32x2){x.x * w.x - x.y * w.y, x.x * w.y + x.y * w.x}; } }
    if (NS == 256) { f32x2 w = tw31;
#pragma unroll
        for (int r = 1; r < R; ++r) { if (r > 1) w = (f32x2){w.x * tw31.x - w.y * tw31.y, w.x * tw31.y + w.y * tw31.x}; const f32x2 x = v[r]; v[r] = (f32x2){x.x * w.x - x.y * w.y, x.x * w.y + x.y * w.x}; } }
    if (ZHI) {
#pragma unroll
        for (int kk = 0; kk < 8; ++kk) { const f32x2 t = v[kk]; const int ti = 2 * kk;
            if (ti == 0) v[kk + 8] = t; else if (ti == 8) v[kk + 8] = (f32x2){t.y, -t.x};
            else { const float c = C32[ti], s = S32[ti]; v[kk + 8] = (f32x2){t.x * c + t.y * s, t.y * c - t.x * s}; } }
        dft_inreg<R, R / 2>(v);
    } else dft_inreg<R>(v);
    const int j0 = (j - k) * R + k;
    LAS f32x2* dp = dst + PI(j0);
    constexpr int QS = (NS == 1) ? 1 : NS + NS / 16;
#pragma unroll
    for (int q = 0; q < R; ++q) dp[q * QS] = v[bitrev(q, 4)];
    __syncthreads();
}
__device__ __forceinline__ void fft8192(LAS f32x2* buf, int tid) {
    pass<16>(buf, 1, tid);
    pass<16>(buf, 16, tid);
    pass<16>(buf, 256, tid);
    pass2_last(buf, tid);
}
}

__device__ __forceinline__ void build_mod(const Ctx& X) {
    const float* c = X.a->in[X.z + I_C]; const float* cc = X.a->in[X.z + I_CCTX]; const float* aw = X.a->in[X.z + I_ADAW]; const float* ab = X.a->in[X.z + I_ADAB];
    float* MOD = (float*)(X.ws + WS_MOD); LAS f32x4* part = (LAS f32x4*)X.lds;
    LAS float* act = (LAS float*)(X.lds + 73728) + X.wave * 1152;
    for (int task = X.vcu; task < NLAYER * 24; task += X.G) {
        const int l = task / 24, cb = task % 24, col = cb * 256 + X.lane * 4, k0 = X.wave * 128;
        __syncthreads();
#pragma unroll
        for (int j = 0; j < 18; ++j) { const int i = X.lane + 64 * j, q = i >> 7, kk = i & 127; const float x = (q < 8) ? c[q * DM + k0 + kk] : cc[k0 + kk]; act[i] = siluf_(x); }
        LDS_WAIT(); asm volatile("" ::: "memory");
        f32x4 acc[9];
#pragma unroll
        for (int q = 0; q < 9; ++q) acc[q] = (f32x4){0.f, 0.f, 0.f, 0.f};
        for (int kb = 0; kb < 128; kb += 8) {
            f32x4 w[8];
#pragma unroll
            for (int j = 0; j < 8; ++j) w[j] = *(const f32x4*)(aw + ((size_t)l * DM + k0 + kb + j) * 6144 + col);
#pragma unroll
            for (int j = 0; j < 8; ++j)
#pragma unroll
                for (int q = 0; q < 9; ++q) acc[q] += act[q * 128 + kb + j] * w[j];
        }
        __syncthreads();
#pragma unroll
        for (int q = 0; q < 9; ++q) part[(X.wave * 9 + q) * 64 + X.lane] = acc[q];
        __syncthreads();
        for (int i = X.tid; i < 9 * 64; i += NTHR) {
            const int q = i >> 6, ln = i & 63; f32x4 sm = *(const f32x4*)(ab + (size_t)l * 6144 + cb * 256 + ln * 4);
#pragma unroll
            for (int w = 0; w < 8; ++w) sm += part[(w * 9 + q) * 64 + ln];
            *(f32x4*)(MOD + ((size_t)l * 9 + q) * 6144 + cb * 256 + ln * 4) = sm;
        }
    }
    __syncthreads();
}
__device__ __forceinline__ void build_rope(const Ctx& X) {
    if (blockIdx.x == 0) {
        float* R = (float*)(X.ws + WS_ROPE); const int pos = X.tid >> 3, idx = X.tid & 7;
        const float inv = __builtin_amdgcn_exp2f(-(float)(2 * idx) * (1.f / 16.f) * 13.287712379549449f);
        float s, c; sincos_rad((float)pos * inv, s, c);
        R[(pos * 8 + idx) * 2] = c; R[(pos * 8 + idx) * 2 + 1] = s;
    }
}
struct S5Lam { float lre, lim, dt; };
__device__ __forceinline__ S5Lam s5_lam(const Ctx& X, int l, int dir, int g, int p) {
    S5Lam r; const int i = ((l * 2 + dir) * S5G + g) * S5P + p;
    r.lre = X.a->in[X.z + I_LRE][i]; r.lim = X.a->in[X.z + I_LIM][i]; r.dt = fast_exp(X.a->in[X.z + I_LDT][(l * 2 + dir) * S5G + g]); return r;
}
__device__ __forceinline__ f32x2 s5_pow(const S5Lam& L, int e) {
    const float m = fast_exp((float)e * L.lre * L.dt); float s, c; sincos_rad_d((double)e * (double)L.lim * (double)L.dt, s, c); return (f32x2){m * c, m * s};
}
__device__ __forceinline__ f32x2 cmul(f32x2 a, f32x2 b) { return (f32x2){a.x * b.x - a.y * b.y, a.x * b.y + a.y * b.x}; }
__device__ __forceinline__ f32x2 s5_coef(const S5Lam& L) {
    const f32x2 lb = s5_pow(L, 1); const float nx = lb.x - 1.f, ny = lb.y, d = 1.f / (L.lre * L.lre + L.lim * L.lim);
    return (f32x2){(nx * L.lre + ny * L.lim) * d, (ny * L.lre - nx * L.lim) * d};
}
__device__ __forceinline__ void aux1_ktab(const Ctx& X, int l, int t0, int t1, int w0, int w1) {
    float* KT = (float*)(X.ws + WS_KTAB);
    LAS f32x2* bb = (LAS f32x2*)X.lds;
    LAS f32x2* pw = bb + 1024;
    LAS f32x2* cc = pw + 512;
    if (X.vcu >= w0 && X.vcu < w1) for (int task = t0 + (X.vcu - w0); task < t1; task += w1 - w0) {
        const int jb = task & 7, g = (task >> 3) & 15, dir = task >> 7;
        const float* bre = X.a->in[X.z + I_BRE] + (size_t)((l * 2 + dir) * S5G + g) * S5P * S5H; const float* bim = X.a->in[X.z + I_BIM] + (size_t)((l * 2 + dir) * S5G + g) * S5P * S5H;
        const float* cre = X.a->in[X.z + I_CRE] + (size_t)((l * 2 + dir) * S5G + g) * S5H * S5P; const float* cim = X.a->in[X.z + I_CIM] + (size_t)((l * 2 + dir) * S5G + g) * S5H * S5P;
        __syncthreads();
        {   const int p = X.tid & 63, jj = X.tid >> 6; const S5Lam L = s5_lam(X, l, dir, g, p);
            pw[jj * 64 + p] = s5_pow(L, jb * 8 + jj);
            const f32x2 cf = s5_coef(L);
#pragma unroll
            for (int k = 0; k < 2; ++k) { const int h = jj * 2 + k; bb[p * 16 + h] = cmul(cf, (f32x2){bre[p * 16 + h], bim[p * 16 + h]}); }
#pragma unroll
            for (int k = 0; k < 2; ++k) { const int i = X.tid + NTHR * k; cc[i] = (f32x2){cre[i], cim[i]}; }
        }
        __syncthreads();
        {   const int hq = X.tid & 3, hp = (X.tid >> 2) & 15, jj = X.tid >> 6;
            float o0 = 0.f, o1 = 0.f, o2 = 0.f, o3 = 0.f;
            for (int p = 0; p < S5P; ++p) { const f32x2 q = cmul(cc[hp * 64 + p], pw[jj * 64 + p]);
                const f32x2 b0 = bb[p * 16 + hq * 4], b1 = bb[p * 16 + hq * 4 + 1], b2 = bb[p * 16 + hq * 4 + 2], b3 = bb[p * 16 + hq * 4 + 3];
                o0 += q.x * b0.x - q.y * b0.y; o1 += q.x * b1.x - q.y * b1.y; o2 += q.x * b2.x - q.y * b2.y; o3 += q.x * b3.x - q.y * b3.y; }
            *(f32x4*)(KT + ((size_t)((dir * S5G + g) * S5LC + jb * 8 + jj) * 16 + hp) * 16 + hq * 4) = (f32x4){o0, o1, o2, o3};
        }
    }
    __syncthreads();
}
__device__ __forceinline__ void aux1_filt(const Ctx& X, int l, int t0, int t1, int w0) {
    LAS float* h1s = (LAS float*)(X.lds);
    LAS float* h2s = h1s + 4096;
    LAS float* w1s = h2s + 4096;
    LAS float* w2s = w1s + 2240;
    LAS float* w3s = w2s + 4224;
    const float* w1 = X.a->in[X.z + I_FW1] + (size_t)l * 33 * 64; const float* b1 = X.a->in[X.z + I_FB1] + l * 64;
    const float* w2 = X.a->in[X.z + I_FW2] + (size_t)l * 64 * 64; const float* b2 = X.a->in[X.z + I_FB2] + l * 64;
    const float* w3 = X.a->in[X.z + I_FW3] + (size_t)l * 64 * 1024; const float* b3 = X.a->in[X.z + I_FB3] + l * 1024;
    const float* fq = X.a->in[X.z + I_FFQ] + l * 128;
    float* FILT = (float*)(X.ws + WS_FILT); float* FILTC = (float*)(X.ws + WS_FILTC);
    const int lane = X.lane, wv = X.wave;
    if (X.vcu >= w0) for (int task = t0 + (X.vcu - w0); task < t1; task += X.G - w0) {
        const int pbk = task >> 2, og = task & 3;
        const bool isctx = pbk >= 64; const int n = isctx ? CTXL : SEQ, idx = (isctx ? pbk - 64 : pbk) * 64 + lane;
        __syncthreads();
        {
            float t1[5], ts[4] = {0.f, 0.f, 0.f, 0.f}, tb3 = 0.f; f32x4 t2[2], t3[8];
#pragma unroll
            for (int j = 0; j < 5; ++j) { const int i = X.tid + NTHR * j; t1[j] = (i < 33 * 64) ? w1[i] : 0.f; }
            if (X.tid < 64) { ts[0] = b1[X.tid]; ts[1] = fq[X.tid]; ts[2] = b2[X.tid]; ts[3] = fq[64 + X.tid]; }
#pragma unroll
            for (int j = 0; j < 2; ++j) t2[j] = *(const f32x4*)(w2 + (X.tid + NTHR * j) * 4);
#pragma unroll
            for (int j = 0; j < 8; ++j) { const int q4 = X.tid + NTHR * j, r = q4 >> 6, c4 = (q4 & 63) * 4; t3[j] = *(const f32x4*)(w3 + r * 1024 + og * 256 + c4); }
            if (X.tid < 256) tb3 = b3[og * 256 + X.tid];
            asm volatile("" ::: "memory");
#pragma unroll
            for (int j = 0; j < 5; ++j) { const int i = X.tid + NTHR * j; if (i < 33 * 64) w1s[i] = t1[j]; }
            if (X.tid < 64) { w1s[2112 + X.tid] = ts[0]; w1s[2176 + X.tid] = ts[1]; w2s[4096 + X.tid] = ts[2]; w2s[4160 + X.tid] = ts[3]; }
#pragma unroll
            for (int j = 0; j < 2; ++j) *(LAS f32x4*)(w2s + (X.tid + NTHR * j) * 4) = t2[j];
#pragma unroll
            for (int j = 0; j < 8; ++j) { const int q4 = X.tid + NTHR * j; *(LAS f32x4*)(w3s + q4 * 4) = t3[j]; }
            if (X.tid < 256) w3s[16384 + X.tid] = tb3;
        }
        float z[33];
        z[0] = (float)idx / (float)(n - 1);
#pragma unroll
        for (int b = 0; b < 16; ++b) { const float fb = 1e-4f + (float)b * ((15.f - 1e-4f) / 15.f); float sn, cs; sincos_rev(((float)idx / (float)n) * fb, sn, cs); z[1 + b] = cs; z[17 + b] = -sn; }
        __syncthreads();
        for (int jj = 0; jj < 8; ++jj) { const int j = wv * 8 + jj; float a = w1s[2112 + j];
#pragma unroll
            for (int i = 0; i < 33; ++i) a += z[i] * w1s[i * 64 + j];
            float sn, cs; sincos_rad(w1s[2176 + j] * a, sn, cs); h1s[j * 64 + lane] = sn; }
        __syncthreads();
        {   float a[8];
#pragma unroll
            for (int jj = 0; jj < 8; ++jj) a[jj] = w2s[4096 + wv * 8 + jj];
            for (int i = 0; i < 64; ++i) { const float hv = h1s[i * 64 + lane]; const f32x4 wa = *(const LAS f32x4*)(w2s + i * 64 + wv * 8), wb = *(const LAS f32x4*)(w2s + i * 64 + wv * 8 + 4);
                a[0] += hv * wa[0]; a[1] += hv * wa[1]; a[2] += hv * wa[2]; a[3] += hv * wa[3]; a[4] += hv * wb[0]; a[5] += hv * wb[1]; a[6] += hv * wb[2]; a[7] += hv * wb[3]; }
#pragma unroll
            for (int jj = 0; jj < 8; ++jj) { float sn, cs; sincos_rad(w2s[4160 + wv * 8 + jj] * a[jj], sn, cs); h2s[(wv * 8 + jj) * 64 + lane] = sn; }
        }
        __syncthreads();
        {   f32x4 acc[8];
#pragma unroll
            for (int q = 0; q < 8; ++q) acc[q] = *(const LAS f32x4*)(w3s + 16384 + wv * 32 + q * 4);
            for (int i = 0; i < 64; ++i) { const float hv = h2s[i * 64 + lane];
#pragma unroll
                for (int q = 0; q < 8; ++q) acc[q] += hv * *(const LAS f32x4*)(w3s + i * 256 + wv * 32 + q * 4); }
            const int dir = og >> 1, o = og & 1; const float tn = z[0];
#pragma unroll
            for (int q = 0; q < 32; ++q) { const int ch = wv * 32 + q;
                const float delta = 3.0701134573253944f + (15.350567286626973f - 3.0701134573253944f) * (float)ch * (1.f / 255.f);
                const float v = acc[q >> 2][q & 3] * fast_exp(-tn * delta);
                if (isctx) FILTC[((size_t)(o * 2 + dir) * HYW + ch) * CTXL + idx] = v;
                else { float* f = FILT + (size_t)(o * HYW + ch) * HYN2;
                    if (dir == 0) f[idx] = v; else if (idx == 0) f[SEQ] = 0.f; else f[HYN2 - idx] = v; } }
        }
    }
    __syncthreads();
}
__device__ __forceinline__ void aux1(const Ctx& X, int l) { aux1_ktab(X, l, 0, 2 * S5G * 8, 0, X.G); aux1_filt(X, l, 0, 68 * 4, 0); }
__device__ __forceinline__ void transpose_item(const float* W, int N, int k0, int n0, bf16_t* dst  , int ldk, const float* gk, LAS float* scr, int lane) {
    f32x4 tv[8]; float tg[8];
#pragma unroll
    for (int i = 0; i < 8; ++i) { const int kk = 8 * i + (lane >> 3), nq = (lane & 7) * 4; tv[i] = *(const f32x4*)(W + (size_t)(k0 + kk) * N + n0 + nq); tg[i] = gk ? gk[k0 + kk] : 1.f; }
    asm volatile("" ::: "memory");
#pragma unroll
    for (int i = 0; i < 8; ++i) { const int kk = 8 * i + (lane >> 3), nq = (lane & 7) * 4; const f32x4 v = tv[i] * tg[i];
        LAS float* d = scr + kk * 33 + nq; d[0] = v[0]; d[1] = v[1]; d[2] = v[2]; d[3] = v[3]; }
    LDS_WAIT(); asm volatile("" ::: "memory");
    const int c = lane & 7;
#pragma unroll
    for (int j = 0; j < 4; ++j) { const int n = (lane >> 3) + 8 * j; const LAS float* s = scr + (8 * c) * 33 + n;
        u32x4 o; o.x = cvt_pk_bf16(s[0 * 33], s[1 * 33]); o.y = cvt_pk_bf16(s[2 * 33], s[3 * 33]); o.z = cvt_pk_bf16(s[4 * 33], s[5 * 33]); o.w = cvt_pk_bf16(s[6 * 33], s[7 * 33]);
        *(u32x4*)(dst + (size_t)n * ldk + 8 * c) = o; }
    LDS_WAIT(); asm volatile("" ::: "memory");
}
__device__ __forceinline__ void aux2(const Ctx& X, int l) {
    const int lane = X.lane;
    {
        bf16_t* TMV = (bf16_t*)(X.ws + WS_TMV); const float* KT = (const float*)(X.ws + WS_KTAB); const float* dvec = X.a->in[X.z + I_S5D] + l * 256;
        for (int row = X.gw; row < S5G * 1024; row += X.ngw) {
            const int g = row >> 10, tp = (row >> 4) & 63, hp = row & 15;
            for (int ck = lane; ck < 160; ck += 64) {
                float v[8];
                if (ck < 128) {
                    const int s = ck >> 1, h0 = (ck & 1) * 8;
                    const int lag0 = (tp - s) > 0 ? (tp - s) : 0, lag1 = (s - tp) > 0 ? (s - tp) : 0;
                    const f32x4* k0 = (const f32x4*)(KT + ((size_t)((0 * S5G + g) * S5LC + lag0) * 16 + hp) * 16 + h0);
                    const f32x4* k1 = (const f32x4*)(KT + ((size_t)((1 * S5G + g) * S5LC + lag1) * 16 + hp) * 16 + h0);
                    const f32x4 a0 = k0[0], a1 = k0[1], b0 = k1[0], b1 = k1[1];
                    const float m0 = (s <= tp) ? 1.f : 0.f, m1 = (s >= tp) ? 1.f : 0.f;
                    const f32x4 r0 = a0 * m0 + b0 * m1, r1 = a1 * m0 + b1 * m1;
                    v[0] = r0[0]; v[1] = r0[1]; v[2] = r0[2]; v[3] = r0[3]; v[4] = r1[0]; v[5] = r1[1]; v[6] = r1[2]; v[7] = r1[3];
                    if (s == tp && (hp >> 3) == (ck & 1)) { const float dd = dvec[g * 16 + hp];
#pragma unroll
                        for (int i = 0; i < 8; ++i) v[i] += (i == (hp & 7)) ? dd : 0.f; }
                } else {
                    const int kk = (ck - 128) * 8, which = kk >> 6, p0 = kk & 63, dir = which >> 1, e = dir ? (64 - tp) : (tp + 1);
                    const float* cre = X.a->in[X.z + I_CRE] + (size_t)(((l * 2 + dir) * S5G + g) * S5H + hp) * S5P; const float* cim = X.a->in[X.z + I_CIM] + (size_t)(((l * 2 + dir) * S5G + g) * S5H + hp) * S5P;
#pragma unroll
                    for (int i = 0; i < 8; ++i) { const S5Lam L = s5_lam(X, l, dir, g, p0 + i); const f32x2 z = cmul((f32x2){cre[p0 + i], cim[p0 + i]}, s5_pow(L, e)); v[i] = (which & 1) ? -z.y : z.x; }
                }
                u32x4 o; o.x = cvt_pk_bf16(v[0], v[1]); o.y = cvt_pk_bf16(v[2], v[3]); o.z = cvt_pk_bf16(v[4], v[5]); o.w = cvt_pk_bf16(v[6], v[7]);
                *(u32x4*)(TMV + (size_t)row * S5K + ck * 8) = o;
            }
        }
    }
    {
        bf16_t* WMT = (bf16_t*)(X.ws + WS_WMT);
        for (int row = X.gw; row < S5G * 256; row += X.ngw) {
            const int g = row >> 8, n = row & 255, dir = n >> 7, part = (n >> 6) & 1, p = n & 63;
            const S5Lam L = s5_lam(X, l, dir, g, p); const f32x2 cf = s5_coef(L);
            const float* bre = X.a->in[X.z + I_BRE] + ((size_t)((l * 2 + dir) * S5G + g) * S5P + p) * S5H; const float* bim = X.a->in[X.z + I_BIM] + ((size_t)((l * 2 + dir) * S5G + g) * S5P + p) * S5H;
            for (int ck = lane; ck < 128; ck += 64) {
                const int s = ck >> 1, h0 = (ck & 1) * 8, e = dir ? s : (63 - s);
                const f32x2 pw = cmul(s5_pow(L, e), cf); float v[8];
#pragma unroll
                for (int i = 0; i < 8; ++i) { const f32x2 z = cmul(pw, (f32x2){bre[h0 + i], bim[h0 + i]}); v[i] = part ? z.y : z.x; }
                u32x4 o; o.x = cvt_pk_bf16(v[0], v[1]); o.y = cvt_pk_bf16(v[2], v[3]); o.z = cvt_pk_bf16(v[4], v[5]); o.w = cvt_pk_bf16(v[6], v[7]);
                *(u32x4*)(WMT + (size_t)row * 1024 + ck * 8) = o;
            }
        }
    }
    {
        const int gt = X.vcu * NTHR + X.tid;
        if (gt < 2 * S5G * S5P) { const int p = gt & 63, g = (gt >> 6) & 15, dir = gt >> 10; const S5Lam L = s5_lam(X, l, dir, g, p); const f32x2 z = s5_pow(L, S5LC);
            *(f32x2*)((float*)(X.ws + WS_LAML) + (size_t)gt * 2) = z; }
    }
    {
        LAS float* scr = (LAS float*)(X.lds + 73728) + X.wave * 2112;
        constexpr int I_WINI = 16 * 53, I_UQ = 6 * 24, I_UKV = 4 * 32, I_OUT = 16 * 32, I_GL = 4 * 8, NIT = I_WINI + I_UQ + I_UKV + I_OUT + I_GL;
        bf16_t* WIN = (bf16_t*)(X.ws + WS_WIN); bf16_t* WUQ = (bf16_t*)(X.ws + WS_WUQ); bf16_t* WUKV = (bf16_t*)(X.ws + WS_WUKV); bf16_t* WOUT = (bf16_t*)(X.ws + WS_WOUT); bf16_t* GLW = (bf16_t*)(X.ws + WS_GLUW);
        for (int it = X.gw; it < NIT; it += X.ngw) {
            int r = it;
            if (r < I_WINI) { const int kb = r / 53, nb = r % 53; transpose_item(X.a->in[X.z + I_WIN] + (size_t)l * DM * P_IN, P_IN, kb * 64, nb * 32, WIN + (size_t)(nb * 32) * DM + kb * 64, DM, nullptr, scr, lane); continue; } r -= I_WINI;
            if (r < I_UQ) { const int kb = r / 24, nb = r % 24; transpose_item(X.a->in[X.z + I_WUQ] + (size_t)l * 384 * QW, QW, kb * 64, nb * 32, WUQ + (size_t)(nb * 32) * 384 + kb * 64, 384, X.a->in[X.z + I_QNG] + l * 384, scr, lane); continue; } r -= I_UQ;
            if (r < I_UKV) { const int kb = r / 32, nb = r % 32; transpose_item(X.a->in[X.z + I_WUKV] + (size_t)l * 256 * KVW, KVW, kb * 64, nb * 32, WUKV + (size_t)(nb * 32) * 256 + kb * 64, 256, X.a->in[X.z + I_KVNG] + l * 256, scr, lane); continue; } r -= I_UKV;
            if (r < I_OUT) { const int kb = r / 32, nb = r % 32; transpose_item(X.a->in[X.z + I_WOUT] + (size_t)l * DM * DM, DM, kb * 64, nb * 32, WOUT + (size_t)(nb * 32) * DM + kb * 64, DM, nullptr, scr, lane); continue; } r -= I_OUT;
            { const int kb = r / 8, nb = r % 8; transpose_item(X.a->in[X.z + I_GLU] + (size_t)l * 256 * 256, 256, kb * 64, nb * 32, GLW + (size_t)(nb * 32) * 256 + kb * 64, 256, nullptr, scr, lane); }
        }
        unsigned zz = 0u; asm volatile("" : "+v"(zz));
        for (int i = X.vcu * NTHR + X.tid; i < (PW - P_IN) * DM / 8; i += X.G * NTHR) *(u32x4*)(WIN + (size_t)P_IN * DM + (size_t)i * 8) = (u32x4){zz, zz, zz, zz};
    }
}
__device__ __forceinline__ void aux2_spec(const Ctx& X, int l, int t0, int t1, int w0) {
    LAS f32x2* bufA = (LAS f32x2*)X.lds; LAS f32x2* bufB = (LAS f32x2*)(X.lds + 69888); LAS f32x2* tw2 = (LAS f32x2*)(X.lds + 139776);
    const float* FILT = (const float*)(X.ws + WS_FILT); f32x2* SPEC = (f32x2*)(X.ws + WS_SPEC);
    if (X.vcu < w0) return;
    __syncthreads();
    fft::build_tw2(tw2, X.tid);
    f32x2 tw31, tw40;
    { float sn, cs; sincos_rev(-(float)(X.tid & 255) * (1.f / 4096.f), sn, cs); tw31 = (f32x2){cs, sn}; }
    { float sn, cs; sincos_rev(-(float)X.tid * (1.f / 8192.f), sn, cs); tw40 = (f32x2){cs, sn}; }
    const int pt = X.tid + (X.tid >> 4);
    for (int task = t0 + (X.vcu - w0); task < t1; task += X.G - w0) {
        int tid = X.tid; asm volatile("" : "+v"(tid));
        const float* fa = FILT + (size_t)(2 * task) * HYN2; const float* fb = fa + HYN2;
        float ra[16], rb[16];
#pragma unroll
        for (int i = 0; i < 16; ++i) { ra[i] = fa[tid + NTHR * i]; rb[i] = fb[tid + NTHR * i]; }
        __syncthreads();
#pragma unroll
        for (int i = 0; i < 16; ++i) bufA[pt + 544 * i] = (f32x2){ra[i], rb[i]};
        __syncthreads();
        fft::pass16_pp<1>(bufA, bufB, tw2, tw31, tid); fft::pass16_pp<16>(bufB, bufA, tw2, tw31, tid); fft::pass16_pp<256>(bufA, bufB, tw2, tw31, tid);
        {   f32x2 w = tw40;
#pragma unroll
            for (int i = 0; i < 8; ++i) { if (i) w = (f32x2){w.x * 0.92387953251128674f + w.y * 0.38268343236508977f, w.y * 0.92387953251128674f - w.x * 0.38268343236508977f};
                const f32x2 a = bufB[pt + 544 * i], b = bufB[pt + 544 * i + 4352];
                const f32x2 bw = {b.x * w.x - b.y * w.y, b.x * w.y + b.y * w.x};
                bufB[pt + 544 * i] = a + bw; bufB[pt + 544 * i + 4352] = a - bw; } }
        __syncthreads();
        f32x2* oa = SPEC + (size_t)(2 * task) * HYN2; f32x2* ob = oa + HYN2;
#pragma unroll
        for (int i = 0; i < 16; ++i) { const int f = tid + NTHR * i, fn = (HYN2 - f) & (HYN2 - 1);
            const f32x2 zf = bufB[pt + 544 * i], zn = bufB[fft::PI(fn)];
            oa[f] = (f32x2){0.5f * (zf.x + zn.x), 0.5f * (zf.y - zn.y)};
            ob[f] = (f32x2){0.5f * (zf.y + zn.y), -0.5f * (zf.x - zn.x)}; }
    }
    __syncthreads();
}
struct TrItem { const float* src; bf16_t* dst; int N, ldk; };
__device__ __forceinline__ TrItem aux3_item(const Ctx& X, int l, int it, bf16_t* W13, bf16_t* W2T) {
    const int e = it / 768, r = it % 768, which = r >> 8, q = r & 255; TrItem t;
    if (which < 2) { const int kb = q >> 4, n0 = (q & 15) * 32; t.N = MOEH; t.ldk = DM;
        t.src = X.a->in[X.z + (which == 0 ? I_W1 : I_W3)] + ((size_t)l * NEXP + e) * DM * MOEH + (size_t)(kb * 64) * MOEH + n0;
        t.dst = W13 + (size_t)(e * 1024 + (n0 >> 7) * 256 + which * 128 + (n0 & 127)) * DM + kb * 64;
    } else { const int kb = q >> 5, nb = q & 31; t.N = DM; t.ldk = MOEH;
        t.src = X.a->in[X.z + I_W2] + ((size_t)l * NEXP + e) * MOEH * DM + (size_t)(kb * 64) * DM + nb * 32;
        t.dst = W2T + (size_t)(e * 1024 + nb * 32) * MOEH + kb * 64; }
    return t;
}
__device__ __forceinline__ void aux3(const Ctx& X, int l) {
    LAS float* scr = (LAS float*)(X.lds) + X.wave * 2112;
    bf16_t* W13 = (bf16_t*)(X.ws + WS_W13); bf16_t* W2T = (bf16_t*)(X.ws + WS_W2T);
    const int lane = X.lane, kq = lane >> 3, nq = (lane & 7) * 4;
    f32x4 cur[8], nxt[8];
    TrItem tc = aux3_item(X, l, X.gw, W13, W2T);
#pragma unroll
    for (int i = 0; i < 8; ++i) cur[i] = *(const f32x4*)(tc.src + (size_t)(8 * i + kq) * tc.N + nq);
    for (int it = X.gw; it < NEXP * 768; it += X.ngw) {
        const int itn = it + X.ngw; const bool more = itn < NEXP * 768;
        TrItem tn = tc;
        if (more) { tn = aux3_item(X, l, itn, W13, W2T);
#pragma unroll
            for (int i = 0; i < 8; ++i) nxt[i] = *(const f32x4*)(tn.src + (size_t)(8 * i + kq) * tn.N + nq); }
#pragma unroll
        for (int i = 0; i < 8; ++i) { LAS float* d = scr + (8 * i + kq) * 33 + nq; d[0] = cur[i][0]; d[1] = cur[i][1]; d[2] = cur[i][2]; d[3] = cur[i][3]; }
        LDS_WAIT(); asm volatile("" ::: "memory");
        const int c = lane & 7;
#pragma unroll
        for (int j = 0; j < 4; ++j) { const int n = (lane >> 3) + 8 * j; const LAS float* sp = scr + (8 * c) * 33 + n;
            u32x4 o; o.x = cvt_pk_bf16(sp[0 * 33], sp[1 * 33]); o.y = cvt_pk_bf16(sp[2 * 33], sp[3 * 33]); o.z = cvt_pk_bf16(sp[4 * 33], sp[5 * 33]); o.w = cvt_pk_bf16(sp[6 * 33], sp[7 * 33]);
            *(u32x4*)(tc.dst + (size_t)n * tc.ldk + 8 * c) = o; }
        LDS_WAIT(); asm volatile("" ::: "memory");
        tc = tn;
#pragma unroll
        for (int i = 0; i < 8; ++i) cur[i] = nxt[i];
    }
}

__device__ __forceinline__ void moe_table(const Ctx& X, int l) {
    LAS int* mt = (LAS int*)(X.lds + MT_OFF);
    const int* ecnt = (const int*)(X.ws + WS_CTL) + CW_ECNT + l * NEXP;
    if (X.tid < NEXP) mt[X.tid] = ecnt[X.tid];
    __syncthreads();
    if (X.tid == 0) { int run = 0; for (int e = 0; e < NEXP; ++e) { mt[32 + e] = run; run += (mt[e] + 255) >> 8; } mt[64] = run; }
    __syncthreads();
}
__device__ __forceinline__ void combine_norm(const Ctx& X, int l) {
    float* XL = (float*)(X.ws + WS_XL); bf16_t* ACT = (bf16_t*)(X.ws + WS_ACT); const float* MOD = (const float*)(X.ws + WS_MOD);
    const bf16_t* YS = (const bf16_t*)(X.ws + WS_GX); const int* SLOT = (const int*)(X.ws + WS_SLOT); const float* GATE = (const float*)(X.ws + WS_GATE);
    const int lane = X.lane;
    const int nrows = (l == NLAYER) ? TL : TT;
    const LAS int* mt = (const LAS int*)(X.lds + MT_OFF);
    struct SlotInfo { int q0, q1; float g0, g1; };
    struct RowData { f32x4 x[4]; u32x2 a[4], b[4]; };
#define CN_SLOT(S_, R_) do { if (l > 0 && (R_) < nrows) { (S_).q0 = SLOT[(R_) * 2]; (S_).q1 = SLOT[(R_) * 2 + 1]; (S_).g0 = GATE[(R_) * 2]; (S_).g1 = GATE[(R_) * 2 + 1]; } } while (0)
#define CN_DATA(D_, S_, R_) do { if ((R_) < nrows) { \
        if (l == 0) { const float* src = ((R_) < TL) ? X.a->in[X.z + I_X] + (size_t)(R_) * DM : X.a->in[X.z + I_CTX] + (size_t)((R_) - TL) * DM; \
            _Pragma("unroll") for (int j = 0; j < 4; ++j) (D_).x[j] = *(const f32x4*)(src + 4 * lane + 256 * j); } \
        else { const int s0 = mt[32 + ((S_).q0 >> 20)] * 256 + ((S_).q0 & 0xfffff), s1 = mt[32 + ((S_).q1 >> 20)] * 256 + ((S_).q1 & 0xfffff);     \
            _Pragma("unroll") for (int j = 0; j < 4; ++j) { const int col = 4 * lane + 256 * j; (D_).x[j] = *(const f32x4*)(XL + (size_t)(R_) * DM + col); \
                (D_).a[j] = *(const u32x2*)(YS + (size_t)s0 * DM + col); (D_).b[j] = *(const u32x2*)(YS + (size_t)s1 * DM + col); } } } } while (0)
    SlotInfo sc, sn, sn2; RowData dc, dn;
    const int step = X.ngw; int row = X.gw;
    CN_SLOT(sc, row); CN_SLOT(sn, row + step);
    CN_DATA(dc, sc, row);
    for (; row < nrows; row += step) {
        CN_DATA(dn, sn, row + step);
        CN_SLOT(sn2, row + 2 * step);
        const int rb = row_b(row);
        f32x4 ma[4], mb[4];
        if (l == 0) {
            const float* g1 = X.a->in[X.z + I_N1G]; const float* m = MOD + (size_t)rb * 6144; f32x4 tg[4], ts[4];
#pragma unroll
            for (int j = 0; j < 4; ++j) { const int col = 4 * lane + 256 * j; tg[j] = *(const f32x4*)(g1 + col); ts[j] = *(const f32x4*)(m + DM + col); mb[j] = *(const f32x4*)(m + col); }
            asm volatile("" ::: "memory");
#pragma unroll
            for (int j = 0; j < 4; ++j) ma[j] = tg[j] * (ts[j] + 1.f);
        } else if (l < NLAYER) { const float* ab = (const float*)(X.ws + WS_MODAB) + ((size_t)l * 9 + rb) * 4 * DM + 2 * DM;
#pragma unroll
            for (int j = 0; j < 4; ++j) { ma[j] = *(const f32x4*)(ab + 4 * lane + 256 * j); mb[j] = *(const f32x4*)(ab + DM + 4 * lane + 256 * j); }
            asm volatile("" ::: "memory"); }
        f32x4 m5v[4];
        if (l > 0) { const float* m5 = MOD + ((size_t)(l - 1) * 9 + rb) * 6144 + 5 * DM;
#pragma unroll
            for (int j = 0; j < 4; ++j) m5v[j] = *(const f32x4*)(m5 + 4 * lane + 256 * j);
            asm volatile("" ::: "memory"); }
        f32x4 v[4];
        if (l == 0) {
#pragma unroll
            for (int j = 0; j < 4; ++j) v[j] = dc.x[j];
        } else {
            const float g0 = sc.g0, g1 = sc.g1;
#pragma unroll
            for (int j = 0; j < 4; ++j) { const u32x2 a = dc.a[j], b = dc.b[j];
                const f32x4 y = {g0 * bflo(a.x) + g1 * bflo(b.x), g0 * bfhi(a.x) + g1 * bfhi(b.x), g0 * bflo(a.y) + g1 * bflo(b.y), g0 * bfhi(a.y) + g1 * bfhi(b.y)};
                v[j] = dc.x[j] + m5v[j] * y; }
        }
        if (l > 0 && l < NLAYER) {
#pragma unroll
            for (int j = 0; j < 4; ++j) *(f32x4*)(XL + (size_t)row * DM + 4 * lane + 256 * j) = v[j];
        }
        float ss = 0.f;
#pragma unroll
        for (int j = 0; j < 4; ++j) ss += (v[j][0] * v[j][0] + v[j][1] * v[j][1]) + (v[j][2] * v[j][2] + v[j][3] * v[j][3]);
        const float rstd = __builtin_amdgcn_rsqf(wave_sum(ss) * (1.f / DM) + EPS);
        if (l == NLAYER) {
            const float* fg = X.a->in[X.z + I_FING];
            f32x4 gv[4];
#pragma unroll
            for (int j = 0; j < 4; ++j) gv[j] = *(const f32x4*)(fg + 4 * lane + 256 * j);
            asm volatile("" ::: "memory");
#pragma unroll
            for (int j = 0; j < 4; ++j) { const int col = 4 * lane + 256 * j; *(f32x4*)(X.a->out + (size_t)row * DM + col) = v[j] * rstd * gv[j]; }
        } else {
#pragma unroll
            for (int j = 0; j < 4; ++j) { const int col = 4 * lane + 256 * j;
                const f32x4 h = (v[j] * rstd) * ma[j] + mb[j];
                u32x2 o; o.x = cvt_pk_bf16(h[0], h[1]); o.y = cvt_pk_bf16(h[2], h[3]); *(u32x2*)(ACT + (size_t)row * DM + col) = o; }
        }
        dc = dn; sc = sn; sn = sn2;
    }
#undef CN_SLOT
#undef CN_DATA
}
__device__ __forceinline__ void kr_hyprep(const Ctx& X, int l) {
    const bf16_t* P = (const bf16_t*)(X.ws + WS_P); bf16_t* KR = (bf16_t*)(X.ws + WS_KR); const float* ROPE = (const float*)(X.ws + WS_ROPE);
    for (int it = X.vcu * NTHR + X.tid; it < TT * 4; it += X.G * NTHR) {
        const int row = it >> 2, q = it & 3;
        const u32x4 a = *(const u32x4*)(P + (size_t)row * PW + P_KR + 8 * q), pb = *(const u32x4*)(P + (size_t)row * PW + P_KR + 8 * (q ^ 1));
        u32x4 o = a;
        if (row < TL) {
            const int tt = row & 4095, pos = (q < 2) ? (tt >> 6) : (tt & 63);
            const f32x4* rp = (const f32x4*)(ROPE + pos * 16); const f32x4 t0 = rp[0], t1 = rp[1], t2 = rp[2], t3 = rp[3];
            const float cs[8] = {t0[0], t0[2], t1[0], t1[2], t2[0], t2[2], t3[0], t3[2]}, sn[8] = {t0[1], t0[3], t1[1], t1[3], t2[1], t2[3], t3[1], t3[3]};
            const float v[8] = {bflo(a.x), bfhi(a.x), bflo(a.y), bfhi(a.y), bflo(a.z), bfhi(a.z), bflo(a.w), bfhi(a.w)};
            const float pr[8] = {bflo(pb.x), bfhi(pb.x), bflo(pb.y), bfhi(pb.y), bflo(pb.z), bfhi(pb.z), bflo(pb.w), bfhi(pb.w)};
            float r[8];
#pragma unroll
            for (int i = 0; i < 8; ++i) r[i] = (q & 1) ? (pr[i] * sn[i] + v[i] * cs[i]) : (v[i] * cs[i] - pr[i] * sn[i]);
            o.x = cvt_pk_bf16(r[0], r[1]); o.y = cvt_pk_bf16(r[2], r[3]); o.z = cvt_pk_bf16(r[4], r[5]); o.w = cvt_pk_bf16(r[6], r[7]);
        }
        *(u32x4*)(KR + (size_t)row * 32 + 8 * q) = o;
    }
    const float* sw = X.a->in[X.z + I_HSW] + (size_t)l * 3 * 768; const float* sb = X.a->in[X.z + I_HSB] + (size_t)l * 768;
    bf16_t* HYT = (bf16_t*)(X.ws + WS_HYT); bf16_t* HYTC = (bf16_t*)(X.ws + WS_HYTC);
    constexpr int HPP = 136;
    LAS unsigned short* tl = (LAS unsigned short*)X.lds;
    constexpr int NT_L = NB * (SEQ / 64) * 6, NT_C = NB * (CTXL / 64) * 6;
    struct KHT { u32x4 v[3]; float w0, w1, w2, bb; };
#define KH_DEC(IT) const bool isc = (IT) >= NT_L; const int r = isc ? (IT) - NT_L : (IT); \
        const int cb = r % 6, q = r / 6, n = isc ? CTXL : SEQ, nb64 = n / 64, tb = q % nb64, b = q / nb64, t0 = tb * 64, ch0 = cb * 128
#define KH_LOAD(D, IT) do { if ((IT) < NT_L + NT_C) { KH_DEC(IT); \
        const bf16_t* src = P + (size_t)(isc ? TL + b * CTXL : b * SEQ) * PW + P_HZ + ch0; \
        _Pragma("unroll") for (int j = 0; j < 3; ++j) { const int ck = X.tid + NTHR * j;                         \
            (D).v[j] = (u32x4){0u, 0u, 0u, 0u}; \
            if (ck < 66 * 16) { const int rr = ck >> 4, c8 = (ck & 15) * 8, t = t0 - 1 + rr; if (t >= 0 && t < n) (D).v[j] = *(const u32x4*)(src + (size_t)t * PW + c8); } } \
        const int ch = ch0 + (X.tid & 127); (D).w0 = sw[ch]; (D).w1 = sw[768 + ch]; (D).w2 = sw[1536 + ch]; (D).bb = sb[ch]; } } while (0)
    KHT cur, nxt;
    KH_LOAD(cur, X.vcu);
    __syncthreads();
    for (int it = X.vcu; it < NT_L + NT_C; it += X.G) {
        KH_DEC(it);
        __syncthreads();
#pragma unroll
        for (int j = 0; j < 3; ++j) { const int ck = X.tid + NTHR * j; if (ck < 66 * 16) { const int rr = ck >> 4, c8 = (ck & 15) * 8; *(LAS u32x4*)(tl + rr * HPP + c8) = cur.v[j]; } }
        KH_LOAD(nxt, it + X.G);
        asm volatile("" ::: "memory");
        __syncthreads();
        {   const int c = X.tid & 127, tq = X.tid >> 7, ch = ch0 + c;
            const float w0 = cur.w0, w1 = cur.w1, w2 = cur.w2, bb = cur.bb;
            float x[18];
#pragma unroll
            for (int k = 0; k < 18; ++k) x[k] = bf2f(tl[(tq * 16 + k) * HPP + c]);
            float z[16];
#pragma unroll
            for (int k = 0; k < 16; ++k) z[k] = w0 * x[k] + w1 * x[k + 1] + w2 * x[k + 2] + bb;
            const int part = ch >> 8, cc = ch & 255;
            bf16_t* dst = (isc ? HYTC + ((size_t)(part * NB + b) * HYW + cc) * CTXL : HYT + ((size_t)(part * NB + b) * HYW + cc) * SEQ) + t0 + tq * 16;
            u32x4 o0, o1;
            o0.x = cvt_pk_bf16(z[0], z[1]); o0.y = cvt_pk_bf16(z[2], z[3]); o0.z = cvt_pk_bf16(z[4], z[5]); o0.w = cvt_pk_bf16(z[6], z[7]);
            o1.x = cvt_pk_bf16(z[8], z[9]); o1.y = cvt_pk_bf16(z[10], z[11]); o1.z = cvt_pk_bf16(z[12], z[13]); o1.w = cvt_pk_bf16(z[14], z[15]);
            *(u32x4*)dst = o0; *(u32x4*)(dst + 8) = o1;
        }
        cur = nxt;
    }
#undef KH_DEC
#undef KH_LOAD
    __syncthreads();
}
__device__ __forceinline__ void s5_scan(const Ctx& X) {
    if (X.wave != 0) return;
    const float* S = (const float*)(X.ws + WS_S5S); bf16_t* UA = (bf16_t*)(X.ws + WS_UA); const float* LAML = (const float*)(X.ws + WS_LAML);
    for (int chain = X.vcu; chain < NB * S5G * 2; chain += X.G) {
        const int dir = chain & 1, g = (chain >> 1) & 15, b = chain >> 5, p = X.lane;
        const f32x2 lamL = *(const f32x2*)(LAML + (size_t)((dir * S5G + g) * S5P + p) * 2);
        f32x2 H = {0.f, 0.f};
        f32x2 s[68];
#pragma unroll
        for (int i = 0; i < 68; ++i) { const int step = i; const int ch = dir ? (step < 4 ? 3 - step : 71 - step) : step;
            const float* sp = S + ((size_t)(g * S5ROWSP + b * S5NCH + ch)) * 256 + dir * 128 + p; s[i] = (f32x2){sp[0], sp[64]}; }
#pragma unroll
        for (int i = 0; i < 68; ++i) { const int step = i; const int ch = dir ? (step < 4 ? 3 - step : 71 - step) : step;
            bf16_t* hp = UA + ((size_t)(g * S5ROWSP + b * S5NCH + ch)) * S5K + 1024 + dir * 128 + p;
            hp[0] = f2bf(H.x); hp[64] = f2bf(H.y);
            H = cmul(lamL, H) + s[i]; }
    }
}
__device__ __forceinline__ void merge_groups(const Ctx& X, int l, int nrows) {
    const bf16_t* S5O = (const bf16_t*)(X.ws + WS_S5O); const bf16_t* MLAO = (const bf16_t*)(X.ws + WS_MLAO); const bf16_t* HYO = (const bf16_t*)(X.ws + WS_HYO); const bf16_t* HYOC = (const bf16_t*)(X.ws + WS_HYOC);
    bf16_t* ACT = (bf16_t*)(X.ws + WS_ACT); const float* mg = X.a->in[X.z + I_MIXG] + l * DM; const int lane = X.lane;
    const f32x4 ga = *(const f32x4*)(mg + 4 * lane), gb0 = *(const f32x4*)(mg + 256 + 8 * lane), gb1 = *(const f32x4*)(mg + 260 + 8 * lane), gc = *(const f32x4*)(mg + 768 + 4 * lane);
    constexpr int HP = 264;
    LAS unsigned short* hyl = (LAS unsigned short*)X.lds;
    for (int tile = X.vcu; tile < nrows / 64; tile += X.G) {
        const int row0 = tile * 64;
        u32x2 av[8]; u32x4 mv4[8];
#pragma unroll
        for (int j = 0; j < 8; ++j) { const int row = row0 + X.wave * 8 + j; av[j] = *(const u32x2*)(S5O + (size_t)row * 256 + 4 * lane); mv4[j] = *(const u32x4*)(MLAO + (size_t)row * 512 + 8 * lane); }
        __syncthreads();
        {   const int c = X.tid >> 1, hf = X.tid & 1;
            const bf16_t* src = (row0 < TL) ? HYO + ((size_t)(row0 >> 12) * HYW + c) * SEQ + (row0 & 4095) + hf * 32
                                            : HYOC + ((size_t)((row0 - TL) >> 8) * HYW + c) * CTXL + ((row0 - TL) & 255) + hf * 32;
            u32x4 v[4];
#pragma unroll
            for (int j = 0; j < 4; ++j) v[j] = *(const u32x4*)(src + 8 * j);
            asm volatile("" ::: "memory");
#pragma unroll
            for (int j = 0; j < 4; ++j) { const unsigned w[4] = {v[j].x, v[j].y, v[j].z, v[j].w};
#pragma unroll
                for (int k = 0; k < 4; ++k) { const int t = hf * 32 + j * 8 + k * 2; hyl[t * HP + c] = (unsigned short)(w[k] & 0xffffu); hyl[(t + 1) * HP + c] = (unsigned short)(w[k] >> 16); } }
        }
        __syncthreads();
#pragma unroll
        for (int j = 0; j < 8; ++j) {
            const int row = row0 + X.wave * 8 + j;
            const u32x2 a = av[j]; const u32x4 m = mv4[j];
            const u32x2 hw = *(const LAS u32x2*)(hyl + (X.wave * 8 + j) * HP + 4 * lane);
            const float hy[4] = {bflo(hw.x), bfhi(hw.x), bflo(hw.y), bfhi(hw.y)};
            const float s5v[4] = {bflo(a.x), bfhi(a.x), bflo(a.y), bfhi(a.y)};
            const float mv[8] = {bflo(m.x), bfhi(m.x), bflo(m.y), bfhi(m.y), bflo(m.z), bfhi(m.z), bflo(m.w), bfhi(m.w)};
            float q0 = 0.f, q1 = 0.f, q2 = 0.f;
#pragma unroll
            for (int i = 0; i < 4; ++i) { q0 += s5v[i] * s5v[i]; q2 += hy[i] * hy[i]; }
#pragma unroll
            for (int i = 0; i < 8; ++i) q1 += mv[i] * mv[i];
            const float r0 = __builtin_amdgcn_rsqf(wave_sum(q0) * (1.f / 256.f) + EPS), r1 = __builtin_amdgcn_rsqf(wave_sum(q1) * (1.f / 512.f) + EPS), r2 = __builtin_amdgcn_rsqf(wave_sum(q2) * (1.f / 256.f) + EPS);
            u32x2 o0; o0.x = cvt_pk_bf16(s5v[0] * r0 * ga[0], s5v[1] * r0 * ga[1]); o0.y = cvt_pk_bf16(s5v[2] * r0 * ga[2], s5v[3] * r0 * ga[3]);
            u32x4 o1; o1.x = cvt_pk_bf16(mv[0] * r1 * gb0[0], mv[1] * r1 * gb0[1]); o1.y = cvt_pk_bf16(mv[2] * r1 * gb0[2], mv[3] * r1 * gb0[3]);
            o1.z = cvt_pk_bf16(mv[4] * r1 * gb1[0], mv[5] * r1 * gb1[1]); o1.w = cvt_pk_bf16(mv[6] * r1 * gb1[2], mv[7] * r1 * gb1[3]);
            u32x2 o2; o2.x = cvt_pk_bf16(hy[0] * r2 * gc[0], hy[1] * r2 * gc[1]); o2.y = cvt_pk_bf16(hy[2] * r2 * gc[2], hy[3] * r2 * gc[3]);
            bf16_t* d = ACT + (size_t)row * DM;
            *(u32x2*)(d + 4 * lane) = o0; *(u32x4*)(d + 256 + 8 * lane) = o1; *(u32x2*)(d + 768 + 4 * lane) = o2;
        }
    }
    __syncthreads();
}
__device__ __forceinline__ void build_modab(const Ctx& X) {
    const float* MOD = (const float*)(X.ws + WS_MOD); float* AB = (float*)(X.ws + WS_MODAB);
    for (int i = X.vcu * NTHR + X.tid; i < NLAYER * 9 * DM; i += X.G * NTHR) { const int c = i & (DM - 1), lr = i >> 10, l = lr / 9;
        const float* m = MOD + (size_t)lr * 6144; const float g2 = X.a->in[X.z + I_N2G][l * DM + c], g1 = X.a->in[X.z + I_N1G][l * DM + c];
        float* o = AB + (size_t)lr * 4 * DM + c;
        o[0] = g2 * (m[4 * DM + c] + 1.f); o[DM] = m[3 * DM + c]; o[2 * DM] = g1 * (m[DM + c] + 1.f); o[3 * DM] = m[c]; }
}
constexpr int RT_PITCH = 2064;
constexpr int RT_WBYTES = 2 * 36 * RT_PITCH;
constexpr int RT_HIST = RT_WBYTES;
__device__ __forceinline__ void norm2_router(const Ctx& X, int l, int RPW) {
    const float* XL = (const float*)(X.ws + WS_XL); bf16_t* ACT = (bf16_t*)(X.ws + WS_ACT); const float* MODAB = (const float*)(X.ws + WS_MODAB);
    float* GATE = (float*)(X.ws + WS_GATE); int* SLOT = (int*)(X.ws + WS_SLOT); int* RTOK = (int*)(X.ws + WS_RTOK);
    LAS unsigned char* W = X.lds; LAS int* hist = (LAS int*)(X.lds + RT_HIST); LAS int* gbase = hist + 32; LAS int* lcnt = hist + 64; LAS int* eidl = hist + 96;
    const int lane = X.lane;
    {   const float* wg = X.a->in[X.z + I_WGRP] + (size_t)l * DM * 4; const float* we = X.a->in[X.z + I_WEXP] + (size_t)l * DM * 32;
        { float t[8];
#pragma unroll
          for (int j = 0; j < 8; ++j) t[j] = wg[X.tid + NTHR * j];
#pragma unroll
          for (int j = 0; j < 8; ++j) { const int i = X.tid + NTHR * j; const float w = t[j]; const unsigned short hi = f2bf(w), lo = f2bf(w - bf2f(hi)); const int o = i & 3, k = i >> 2;
            *(LAS unsigned short*)(W + o * RT_PITCH + k * 2) = hi; *(LAS unsigned short*)(W + (36 + o) * RT_PITCH + k * 2) = lo; } }
        for (int b = 0; b < 4; ++b) { float t[16];
#pragma unroll
          for (int j = 0; j < 16; ++j) t[j] = we[X.tid + NTHR * (b * 16 + j)];
#pragma unroll
          for (int j = 0; j < 16; ++j) { const int i = X.tid + NTHR * (b * 16 + j); const float w = t[j]; const unsigned short hi = f2bf(w), lo = f2bf(w - bf2f(hi)); const int o = 4 + (i & 31), k = i >> 5;
            *(LAS unsigned short*)(W + o * RT_PITCH + k * 2) = hi; *(LAS unsigned short*)(W + (36 + o) * RT_PITCH + k * 2) = lo; } }
        if (X.tid < 32) hist[X.tid] = 0;
    }
    __syncthreads();
    const float* g2 = X.a->in[X.z + I_N2G] + l * DM;
    const int row0 = blockIdx.x * RPW, tok = lane & 15, kg = lane >> 4;
    const int orow[3] = {tok, 16 + tok, (32 + tok) < 36 ? 32 + tok : 35};
    struct RLd { f32x4 x[2], a[2], b[2]; };
#define RT_LOAD(D, S_) do { const int s_ = ((S_) < se) ? (S_) : se - 1;        \
        _Pragma("unroll") for (int q = 0; q < 2; ++q) { (D).x[q] = *(const f32x4*)(xr + 32 * s_ + 4 * q); (D).a[q] = *(const f32x4*)(ab + 32 * s_ + 4 * q); (D).b[q] = *(const f32x4*)(ab + DM + 32 * s_ + 4 * q); } } while (0)
#define RT_STEP(C, S_, ACC) do { const int s = (S_); \
            float h[8]; \
            _Pragma("unroll") for (int q = 0; q < 2; ++q) { const f32x4 v = ((C).x[q] * rstd) * (C).a[q] + (C).b[q]; h[4 * q] = v[0]; h[4 * q + 1] = v[1]; h[4 * q + 2] = v[2]; h[4 * q + 3] = v[3]; } \
            u32x4 hi, lo; \
            hi.x = cvt_pk_bf16(h[0], h[1]); hi.y = cvt_pk_bf16(h[2], h[3]); hi.z = cvt_pk_bf16(h[4], h[5]); hi.w = cvt_pk_bf16(h[6], h[7]); \
            lo.x = cvt_pk_bf16(h[0] - bflo(hi.x), h[1] - bfhi(hi.x)); lo.y = cvt_pk_bf16(h[2] - bflo(hi.y), h[3] - bfhi(hi.y)); \
            lo.z = cvt_pk_bf16(h[4] - bflo(hi.z), h[5] - bfhi(hi.z)); lo.w = cvt_pk_bf16(h[6] - bflo(hi.w), h[7] - bfhi(hi.w)); \
            if (valid) *(u32x4*)(ACT + (size_t)row * DM + 32 * s + 8 * kg) = hi; \
            const bf16x8 bh = *reinterpret_cast<const bf16x8*>(&hi), bl = *reinterpret_cast<const bf16x8*>(&lo); \
            _Pragma("unroll") for (int ot = 0; ot < 3; ++ot) { \
                const bf16x8 ah = *(const LAS bf16x8*)(W + orow[ot] * RT_PITCH + (32 * s + 8 * kg) * 2), al = *(const LAS bf16x8*)(W + (36 + orow[ot]) * RT_PITCH + (32 * s + 8 * kg) * 2); \
                (ACC)[ot] = __builtin_amdgcn_mfma_f32_16x16x32_bf16(ah, bh, (ACC)[ot], 0, 0, 0); \
                (ACC)[ot] = __builtin_amdgcn_mfma_f32_16x16x32_bf16(al, bh, (ACC)[ot], 0, 0, 0); \
                (ACC)[ot] = __builtin_amdgcn_mfma_f32_16x16x32_bf16(ah, bl, (ACC)[ot], 0, 0, 0); } } while (0)
#define RT_KLOOP(TILE, S0, NS, ACC) do { \
        const int ti = (TILE) * 16 + tok; const bool valid = ti < RPW; const int row = row0 + (valid ? ti : RPW - 1); \
        const float* xr = XL + (size_t)row * DM + 8 * kg; const float* ab = MODAB + ((size_t)l * 9 + row_b(row)) * 4 * DM + 8 * kg; \
        float ss; \
        {   const f32x4* sp = (const f32x4*)((const float*)(X.ws + WS_SSQP) + (size_t)row * 32); const f32x4 s0 = sp[0], s1 = sp[1], s2 = sp[2], s3 = sp[3]; \
            ss = (((s0[0] + s0[1]) + (s0[2] + s0[3])) + ((s1[0] + s1[1]) + (s1[2] + s1[3]))) + (((s2[0] + s2[1]) + (s2[2] + s2[3])) + ((s3[0] + s3[1]) + (s3[2] + s3[3]))); } \
        const float rstd = __builtin_amdgcn_rsqf(ss * (1.f / DM) + EPS); \
        _Pragma("unroll") for (int ot = 0; ot < 3; ++ot) (ACC)[ot] = (f32x4){0.f, 0.f, 0.f, 0.f}; \
        const int se = (S0) + (NS); \
        RLd c0, c1, c2, c3; RT_LOAD(c0, (S0)); RT_LOAD(c1, (S0) + 1); RT_LOAD(c2, (S0) + 2); \
        _Pragma("unroll 1") for (int sb = (S0); sb < se; sb += 4) { \
            RT_LOAD(c3, sb + 3); RT_STEP(c0, sb, ACC); \
            RT_LOAD(c0, sb + 4); RT_STEP(c1, sb + 1, ACC); \
            RT_LOAD(c1, sb + 5); RT_STEP(c2, sb + 2, ACC); \
            RT_LOAD(c2, sb + 6); RT_STEP(c3, sb + 3, ACC); } } while (0)
#define RT_FINISH(TILE, ACC) do { \
        const int ti = (TILE) * 16 + tok; const bool valid = ti < RPW; const int row = row0 + (valid ? ti : RPW - 1); \
        float lg[48]; \
        _Pragma("unroll") for (int ot = 0; ot < 3; ++ot) _Pragma("unroll") for (int i = 0; i < 4; ++i) { \
                lg[16 * ot + i] = (ACC)[ot][i]; \
                _Pragma("unroll") for (int k2 = 1; k2 < 4; ++k2) lg[16 * ot + 4 * k2 + i] = __shfl((ACC)[ot][i], tok + 16 * k2); } \
        if (kg == 0 && valid) { \
            float gm = lg[0]; int gi = 0; \
            _Pragma("unroll") for (int i = 1; i < 4; ++i) { if (lg[i] > gm) { gm = lg[i]; gi = i; } } \
            float den = 0.f; \
            _Pragma("unroll") for (int i = 0; i < 4; ++i) den += fast_exp(lg[i] - gm); \
            const float gw = 1.f / den; \
            float cand[8]; \
            _Pragma("unroll") for (int j = 0; j < 8; ++j) { cand[j] = lg[4 + j]; \
                _Pragma("unroll") for (int g = 1; g < 4; ++g) cand[j] = (gi == g) ? lg[4 + 8 * g + j] : cand[j]; } \
            float v0 = -3.0e38f, v1 = -3.0e38f; int i0 = 0, i1 = 0; \
            _Pragma("unroll") for (int i = 0; i < 8; ++i) { const float v = cand[i]; \
                if (v > v0) { v1 = v0; i1 = i0; v0 = v; i0 = i; } else if (v > v1) { v1 = v; i1 = i; } } \
            const float e1 = fast_exp(v1 - v0), inv = 1.f / (1.f + e1); \
            const int e0i = gi * 8 + i0, e1i = gi * 8 + i1; \
            eidl[ti * 2] = e0i; eidl[ti * 2 + 1] = e1i; GATE[row * 2] = gw * inv; GATE[row * 2 + 1] = gw * e1 * inv; \
            atomicAdd((int*)&hist[e0i], 1); atomicAdd((int*)&hist[e1i], 1); } } while (0)
    f32x4 pacc[3];
    {   f32x4 acc[3]; RT_KLOOP(X.wave, 0, 32, acc); RT_FINISH(X.wave, acc); }
    if (RPW > 128) {
    RT_KLOOP(8, 4 * X.wave, 4, pacc);
    __syncthreads();
    {   LAS f32x4* P = (LAS f32x4*)W;
#pragma unroll
        for (int ot = 0; ot < 3; ++ot) P[(X.wave * 3 + ot) * 64 + lane] = pacc[ot]; }
    __syncthreads();
    if (X.wave == 0) {   const LAS f32x4* P = (const LAS f32x4*)W; f32x4 acc[3];
#pragma unroll
        for (int ot = 0; ot < 3; ++ot) { acc[ot] = P[ot * 64 + lane];
#pragma unroll
            for (int w = 1; w < NWAVES; ++w) acc[ot] += P[(w * 3 + ot) * 64 + lane]; }
        RT_FINISH(8, acc); }
    }
#undef RT_LOAD
#undef RT_STEP
#undef RT_KLOOP
#undef RT_FINISH
    __syncthreads();
    if (X.tid < 32) { gbase[X.tid] = (int)atomicAdd((unsigned*)(X.ws + WS_CTL) + CW_ECNT + l * NEXP + X.tid, (unsigned)hist[X.tid]); lcnt[X.tid] = 0; }
    __syncthreads();
    if (X.tid < 2 * RPW) { const int e = eidl[X.tid], pos = gbase[e] + atomicAdd((int*)&lcnt[e], 1), tokr = row0 + (X.tid >> 1);
        RTOK[(size_t)e * MOE_CAP + pos] = tokr; SLOT[tokr * 2 + (X.tid & 1)] = (e << 20) | pos; }
}

namespace attn {
constexpr int NW = 8, QBLK = 32, KVBLK = 64;
constexpr float SCALE = 0.10206207261596575f;
constexpr float THR = 8.f;
constexpr int NSLOT = 3, SHM_V = KVBLK * DV * 2  , SHM_K = KVBLK * 256  , SHM_ATTN = NSLOT * (SHM_V + SHM_K) + NW * 64 * 4;
#define KSWZ(row, colB) ((row) * 256 + ((colB) ^ (((row) & 7) << 4)))
#define SBAR() __builtin_amdgcn_sched_barrier(0)
#define QK_PIPE() do { __builtin_amdgcn_sched_group_barrier(0x002, 8, 0); __builtin_amdgcn_sched_group_barrier(0x100, 12, 0); \
    _Pragma("unroll") for (int g_ = 0; g_ < 14; ++g_) { __builtin_amdgcn_sched_group_barrier(0x008, 1, 0); __builtin_amdgcn_sched_group_barrier(0x002, 4, 0); } } while (0)
__device__ __forceinline__ int crow(int r, int hi) { return (r & 3) + 8 * (r >> 2) + 4 * hi; }
constexpr float C_ATT = SCALE * 1.4426950408889634f;
constexpr float THRL = THR * 1.4426950408889634f;
__device__ __forceinline__ void partialSM(f32x16& p0, f32x16& p1, float& m_reg, float& alpha, bf16x8& qm, bool first, int hi) {
  float pmax = p0[0];
#pragma unroll
  for (int r = 1; r < 16; ++r) pmax = fmaxf(pmax, p0[r]);
#pragma unroll
  for (int r = 0; r < 16; ++r) pmax = fmaxf(pmax, p1[r]);
  { auto rr = __builtin_amdgcn_permlane32_swap(__float_as_uint(pmax), __float_as_uint(pmax), false, false);
    pmax = fmaxf(__uint_as_float(rr[0]), __uint_as_float(rr[1])); }
  if (__builtin_expect(!first && __all(pmax <= THRL), 1)) { alpha = 1.f; }
  else {
    const float dlt = first ? pmax : fmaxf(pmax, 0.f);
    m_reg += dlt; alpha = first ? 1.f : __builtin_amdgcn_exp2f(-dlt);
#pragma unroll
    for (int r = 0; r < 16; ++r) { p0[r] -= dlt; p1[r] -= dlt; }
    const float nm = -m_reg; const unsigned w = cvt_pk_bf16(nm, 0.f) & 0xffffu; const float rem = nm - __uint_as_float(w << 16);
    const unsigned w2 = (hi == 0) ? (w | (cvt_pk_bf16(rem, 0.f) << 16)) : 0u;
    const u32x4 q4 = {w2, 0u, 0u, 0u}; qm = *reinterpret_cast<const bf16x8*>(&q4);
  }
#pragma unroll
  for (int r = 0; r < 16; ++r) p0[r] = __builtin_amdgcn_exp2f(p0[r]);
}
__device__ __forceinline__ void finishSM(f32x16& p0, f32x16& p1, bf16x8& pa0, bf16x8& pa1, bf16x8& pa2, bf16x8& pa3) {
#pragma unroll
  for (int r = 0; r < 16; ++r) p1[r] = __builtin_amdgcn_exp2f(p1[r]);
#define PK4(P, BASE, OUT) do { unsigned a0 = cvt_pk_bf16(P[BASE + 0], P[BASE + 1]), a1 = cvt_pk_bf16(P[BASE + 2], P[BASE + 3]);   \
    unsigned b0 = cvt_pk_bf16(P[BASE + 4], P[BASE + 5]), b1 = cvt_pk_bf16(P[BASE + 6], P[BASE + 7]);                              \
    auto r0 = __builtin_amdgcn_permlane32_swap(a0, b0, false, false); auto r1 = __builtin_amdgcn_permlane32_swap(a1, b1, false, false); \
    u32x4 w = {r0[0], r1[0], r0[1], r1[1]}; OUT = *reinterpret_cast<bf16x8*>(&w); } while (0)
  PK4(p0, 0, pa0); PK4(p0, 8, pa1); PK4(p1, 0, pa2); PK4(p1, 8, pa3);
#undef PK4
}
__device__ __forceinline__ void qkt(f32x16& p0, f32x16& p1, const LAS char* Ks, const bf16x8* qr, bf16x8 qm, int r32, int hi) {
  const u32x4 k1 = {hi == 0 ? 0x3f803f80u : 0u, 0u, 0u, 0u}; const bf16x8 kone = *reinterpret_cast<const bf16x8*>(&k1);
  p0 = __builtin_amdgcn_mfma_f32_32x32x16_bf16(kone, qm, f32x16{}, 0, 0, 0);
  p1 = __builtin_amdgcn_mfma_f32_32x32x16_bf16(kone, qm, f32x16{}, 0, 0, 0);
#pragma unroll
  for (int d0 = 0; d0 < 6; ++d0) { const int cb = (d0 * 16 + hi * 8) * 2;
    const bf16x8 b0 = *(const LAS bf16x8*)(Ks + KSWZ(r32, cb));
    const bf16x8 b1 = *(const LAS bf16x8*)(Ks + KSWZ(32 + r32, cb));
    p0 = __builtin_amdgcn_mfma_f32_32x32x16_bf16(b0, qr[d0], p0, 0, 0, 0);
    p1 = __builtin_amdgcn_mfma_f32_32x32x16_bf16(b1, qr[d0], p1, 0, 0, 0); }
}
__device__ __forceinline__ int v_st(int k, int c) { const int kk = (k & ~0xC) | ((k & 4) << 1) | ((k & 8) >> 1); return ((kk >> 3) * 2 + (c >> 5)) * 512 + ((kk & 7) * 32 + (c & 31)) * 2; }
__device__ __forceinline__ int v_rd_base(int lane) { return ((lane & 3) << 3) | (((lane >> 2) & 3) << 6) | (((lane >> 4) & 1) << 5) | (((lane >> 5) & 1) << 8); }
constexpr int v_rd_off(int d0, int ks, int half) { return d0 * 512 + ks * 2048 + half * 1024; }
template <int OFF> __device__ __forceinline__ s16x4 tr_read(int vb) {
  s16x4 r; asm volatile("ds_read_b64_tr_b16 %0, %1 offset:%2" : "=&v"(r) : "v"(vb), "i"(OFF) : "memory"); return r;
}
template <int D0> __device__ __forceinline__ void pv_one(f32x16& od, int vb, bf16x8 pa0, bf16x8 pa1, bf16x8 pa2, bf16x8 pa3) {
  const s16x4 l0 = tr_read<v_rd_off(D0, 0, 0)>(vb), h0 = tr_read<v_rd_off(D0, 0, 1)>(vb), l1 = tr_read<v_rd_off(D0, 1, 0)>(vb), h1 = tr_read<v_rd_off(D0, 1, 1)>(vb);
  const s16x4 l2 = tr_read<v_rd_off(D0, 2, 0)>(vb), h2 = tr_read<v_rd_off(D0, 2, 1)>(vb), l3 = tr_read<v_rd_off(D0, 3, 0)>(vb), h3 = tr_read<v_rd_off(D0, 3, 1)>(vb);
  asm volatile("s_waitcnt lgkmcnt(0)" ::: "memory"); SBAR();
#define PK(L, H) (bf16x8){L[0], L[1], L[2], L[3], H[0], H[1], H[2], H[3]}
  od = __builtin_amdgcn_mfma_f32_32x32x16_bf16(pa0, PK(l0, h0), od, 0, 0, 0);
  od = __builtin_amdgcn_mfma_f32_32x32x16_bf16(pa1, PK(l1, h1), od, 0, 0, 0);
  od = __builtin_amdgcn_mfma_f32_32x32x16_bf16(pa2, PK(l2, h2), od, 0, 0, 0);
  od = __builtin_amdgcn_mfma_f32_32x32x16_bf16(pa3, PK(l3, h3), od, 0, 0, 0);
#undef PK
}
__device__ __forceinline__ void pv_d0(f32x16* o, int vb, bf16x8 pa0, bf16x8 pa1, bf16x8 pa2, bf16x8 pa3) {
  const s16x4 a0 = tr_read<v_rd_off(0, 0, 0)>(vb), b0 = tr_read<v_rd_off(0, 0, 1)>(vb), c0 = tr_read<v_rd_off(1, 0, 0)>(vb), d0 = tr_read<v_rd_off(1, 0, 1)>(vb);
  const s16x4 a1 = tr_read<v_rd_off(0, 1, 0)>(vb), b1 = tr_read<v_rd_off(0, 1, 1)>(vb), c1 = tr_read<v_rd_off(1, 1, 0)>(vb), d1 = tr_read<v_rd_off(1, 1, 1)>(vb);
  const s16x4 a2 = tr_read<v_rd_off(0, 2, 0)>(vb), b2 = tr_read<v_rd_off(0, 2, 1)>(vb), c2 = tr_read<v_rd_off(1, 2, 0)>(vb), d2 = tr_read<v_rd_off(1, 2, 1)>(vb);
  const s16x4 a3 = tr_read<v_rd_off(0, 3, 0)>(vb), b3 = tr_read<v_rd_off(0, 3, 1)>(vb), c3 = tr_read<v_rd_off(1, 3, 0)>(vb), d3 = tr_read<v_rd_off(1, 3, 1)>(vb);
  asm volatile("s_waitcnt lgkmcnt(0)" ::: "memory"); SBAR();
#define PK(L, H) (bf16x8){L[0], L[1], L[2], L[3], H[0], H[1], H[2], H[3]}
  o[0] = __builtin_amdgcn_mfma_f32_32x32x16_bf16(pa0, PK(a0, b0), o[0], 0, 0, 0);
  o[1] = __builtin_amdgcn_mfma_f32_32x32x16_bf16(pa0, PK(c0, d0), o[1], 0, 0, 0);
  o[0] = __builtin_amdgcn_mfma_f32_32x32x16_bf16(pa1, PK(a1, b1), o[0], 0, 0, 0);
  o[1] = __builtin_amdgcn_mfma_f32_32x32x16_bf16(pa1, PK(c1, d1), o[1], 0, 0, 0);
  o[0] = __builtin_amdgcn_mfma_f32_32x32x16_bf16(pa2, PK(a2, b2), o[0], 0, 0, 0);
  o[1] = __builtin_amdgcn_mfma_f32_32x32x16_bf16(pa2, PK(c2, d2), o[1], 0, 0, 0);
  o[0] = __builtin_amdgcn_mfma_f32_32x32x16_bf16(pa3, PK(a3, b3), o[0], 0, 0, 0);
  o[1] = __builtin_amdgcn_mfma_f32_32x32x16_bf16(pa3, PK(c3, d3), o[1], 0, 0, 0);
  { const u32x4 o1 = {0x3f803f80u, 0x3f803f80u, 0x3f803f80u, 0x3f803f80u}; const bf16x8 ones = *reinterpret_cast<const bf16x8*>(&o1);
    o[2] = __builtin_amdgcn_mfma_f32_32x32x16_bf16(pa0, ones, o[2], 0, 0, 0); o[2] = __builtin_amdgcn_mfma_f32_32x32x16_bf16(pa1, ones, o[2], 0, 0, 0);
    o[2] = __builtin_amdgcn_mfma_f32_32x32x16_bf16(pa2, ones, o[2], 0, 0, 0); o[2] = __builtin_amdgcn_mfma_f32_32x32x16_bf16(pa3, ones, o[2], 0, 0, 0); }
#undef PK
}
__device__ __forceinline__ int key_row(int b, int kk) { return kk < CTXL ? TL + b * CTXL + kk : b * SEQ + (kk - CTXL); }

__device__ __forceinline__ void attn_phase(const bf16_t* __restrict__ Q, const bf16_t* __restrict__ KV, const bf16_t* __restrict__ KR, bf16_t* __restrict__ O,
                                           int vcu, int G, LAS char* lds, int wave_, bool with_ctx) {
  constexpr int NLU = NB * NHEAD * 16; const int NCU = with_ctx ? NB * NHEAD : 0;
  const int nl = (vcu < NLU) ? (NLU - vcu + G - 1) / G : 0, nc = (vcu < NCU) ? (NCU - vcu + G - 1) / G : 0, nu = nl + nc;
  if (nu == 0) return;
  int tid_ = wave_ * 64 + lane_id(); asm volatile("" : "+v"(tid_));
  const int tid = tid_, wid = tid >> 6, lane = tid & 63, r32 = lane & 31, hi = lane >> 5;
  LAS char* V_lds = lds; LAS char* K_lds = lds + NSLOT * SHM_V;
  LAS float* ws = (LAS float*)(lds + NSLOT * (SHM_V + SHM_K)) + wid * 64; LAS float* al_l = ws + 32;
  const int sr = tid >> 4, c16 = tid & 15, vr = tid >> 3, c8 = tid & 7;
  const bool kact = c16 < 12;
  const int kst0 = KSWZ(sr, c16 * 16), kst1 = KSWZ(32 + sr, c16 * 16), vst = v_st(vr, c8 * 8);
  const int vb0 = (int)(uintptr_t)V_lds + v_rd_base(lane);
  struct { bf16x8 ks0, ks1, vs; } sr_[2];
  bf16x8 qr[6];
  const unsigned kstr = (c16 < 8) ? (unsigned)(KVW * 2) : 64u;
  const char* P0; const char* P1; const char* PV0;
#define UPTR(hh) do { P0 = (c16 < 8) ? (const char*)(KV + (size_t)sr * KVW + (hh) * 128 + c16 * 8) : (const char*)(KR + (size_t)sr * 32 + (c16 - 8) * 8); \
    P1 = P0 + 32 * kstr; PV0 = (const char*)(KV + (size_t)vr * KVW + (hh) * 128 + 64 + c8 * 8); } while (0)
#define UDEC(v, b_, h_, q0_, nt_) do { if ((v) < nl) { const int u_ = vcu + (v) * G, bh_ = u_ >> 4; b_ = bh_ >> 3; h_ = bh_ & 7; q0_ = b_ * SEQ + (u_ & 15) * 256; nt_ = NKEY / 64; } \
    else { const int u_ = vcu + ((v) - nl) * G; b_ = u_ >> 3; h_ = u_ & 7; q0_ = TL + b_ * CTXL; nt_ = CTXL / 64; } } while (0)
#define QLOAD(q0_, hh) do { const bf16_t* Qw_ = Q + (size_t)((q0_) + wid * QBLK + r32) * QW + (hh) * DQK + hi * 8; \
    _Pragma("unroll") for (int d0 = 0; d0 < 6; ++d0) qr[d0] = *(const bf16x8*)(Qw_ + d0 * 16); } while (0)
#define SLOADB(i, k0, bb) do { const unsigned _rb = (unsigned)key_row((bb), (k0)); \
    if (kact) { sr_[i].ks0 = *(const bf16x8*)(P0 + (size_t)_rb * kstr); sr_[i].ks1 = *(const bf16x8*)(P1 + (size_t)_rb * kstr); } \
    sr_[i].vs = *(const bf16x8*)(PV0 + (size_t)_rb * (KVW * 2)); } while (0)
#define SLOAD(i, k0) SLOADB(i, k0, b)
#define SWRITE(slot, i) do { *(LAS bf16x8*)(V_lds + (slot) * SHM_V + vst) = sr_[i].vs; \
    if (kact) { *(LAS bf16x8*)(K_lds + (slot) * SHM_K + kst0) = sr_[i].ks0; *(LAS bf16x8*)(K_lds + (slot) * SHM_K + kst1) = sr_[i].ks1; } } while (0)
#define SWAIT() asm volatile("s_waitcnt vmcnt(3)" ::: "memory")
#define RESC(a) do { if (__any((a) < 1.f)) { if (hi == 0) al_l[r32] = (a); asm volatile("s_waitcnt lgkmcnt(0)" ::: "memory"); \
    _Pragma("unroll") for (int d = 0; d < 3; ++d) _Pragma("unroll") for (int r = 0; r < 16; ++r) o[d][r] *= al_l[crow(r, hi)]; } } while (0)
  int b, h, qrow0, NT; UDEC(0, b, h, qrow0, NT);
  UPTR(h); QLOAD(qrow0, h); SLOAD(0, 0);
  for (int v = 0; v < nu; ++v) {
  float m_reg = 0.f; f32x16 o[3] = {};
  f32x16 pA0, pA1, pB0, pB1; float alA, alB; bf16x8 pa0, pa1, pa2, pa3; bf16x8 qm = {0, 0, 0, 0, 0, 0, 0, 0};
  SWRITE(0, 0); __syncthreads();
  qkt(pA0, pA1, K_lds, qr, qm, r32, hi); partialSM(pA0, pA1, m_reg, alA, qm, true, hi);
  SLOAD(1, KVBLK); if (2 < NT) SLOAD(0, 2 * KVBLK);
  SWAIT(); SWRITE(1, 1); __syncthreads();
  int sj = 1;
  for (int j = 1; j + 1 < NT; j += 2) {
    const int s1 = (sj == 2) ? 0 : sj + 1, s2 = (s1 == 2) ? 0 : s1 + 1, sp = (sj == 0) ? 2 : sj - 1;
    SBAR(); qkt(pB0, pB1, K_lds + sj * SHM_K, qr, qm, r32, hi);
    finishSM(pA0, pA1, pa0, pa1, pa2, pa3); QK_PIPE(); SBAR();
    SLOAD(1, (j + 2) * KVBLK); SBAR();
    pv_d0(o, vb0 + sp * SHM_V, pa0, pa1, pa2, pa3); partialSM(pB0, pB1, m_reg, alB, qm, false, hi);
    SWAIT(); SWRITE(s1, 0);
    RESC(alB); __syncthreads();
    SBAR(); qkt(pA0, pA1, K_lds + s1 * SHM_K, qr, qm, r32, hi);
    finishSM(pB0, pB1, pa0, pa1, pa2, pa3); QK_PIPE(); SBAR();
    if (j + 3 < NT) SLOAD(0, (j + 3) * KVBLK); SBAR();
    pv_d0(o, vb0 + sj * SHM_V, pa0, pa1, pa2, pa3); partialSM(pA0, pA1, m_reg, alA, qm, false, hi);
    SWAIT(); SWRITE(s2, 1);
    RESC(alA); __syncthreads();
    sj = s2;
  }
  const int oq0 = qrow0, oh = h;
  { const int sp = (sj == 0) ? 2 : sj - 1;
    SBAR(); qkt(pB0, pB1, K_lds + sj * SHM_K, qr, qm, r32, hi);
    finishSM(pA0, pA1, pa0, pa1, pa2, pa3); SBAR();
    if (v + 1 < nu) { UDEC(v + 1, b, h, qrow0, NT); UPTR(h); QLOAD(qrow0, h); SLOAD(0, 0); }
    SBAR();
    pv_d0(o, vb0 + sp * SHM_V, pa0, pa1, pa2, pa3); partialSM(pB0, pB1, m_reg, alB, qm, false, hi);
    RESC(alB);
    finishSM(pB0, pB1, pa0, pa1, pa2, pa3); SBAR();
    pv_d0(o, vb0 + sj * SHM_V, pa0, pa1, pa2, pa3); }
  float rli[16];
#pragma unroll
  for (int r = 0; r < 16; ++r) rli[r] = __builtin_amdgcn_rcpf(o[2][r]);
  bf16_t* Ow = O + (size_t)(oq0 + wid * QBLK) * 512 + oh * DV;
#pragma unroll
  for (int r = 0; r < 16; ++r) { const int orow = crow(r, hi);
#pragma unroll
    for (int d0 = 0; d0 < 2; ++d0) Ow[(size_t)orow * 512 + d0 * 32 + r32] = f2bf(o[d0][r] * rli[r]); }
  __syncthreads();
  }
#undef UPTR
#undef UDEC
#undef QLOAD
#undef SLOADB
#undef SLOAD
#undef SWRITE
#undef SWAIT
#undef RESC
}
#undef KSWZ
}

__device__ __forceinline__ void hyena_conv(const Ctx& X, int l) {
    LAS f32x2* bufA = (LAS f32x2*)X.lds; LAS f32x2* bufB = (LAS f32x2*)(X.lds + 69888); LAS f32x2* tw2 = (LAS f32x2*)(X.lds + 139776);
    const f32x2* SPEC = (const f32x2*)(X.ws + WS_SPEC); const bf16_t* HYT = (const bf16_t*)(X.ws + WS_HYT); bf16_t* HYO = (bf16_t*)(X.ws + WS_HYO);
    const float* hb = X.a->in[X.z + I_HBIAS] + l * 2 * HYW;
    __syncthreads();
    fft::build_tw2(tw2, X.tid);
    f32x2 tw31, tw40;
    { float sn, cs; sincos_rev(-(float)(X.tid & 255) * (1.f / 4096.f), sn, cs); tw31 = (f32x2){cs, sn}; }
    { float sn, cs; sincos_rev(-(float)X.tid * (1.f / 8192.f), sn, cs); tw40 = (f32x2){cs, sn}; }
    unsigned short nv0[8], nv1[8];
#define HY_LOADV(U) do { int tid_ = X.tid; asm volatile("" : "+v"(tid_)); const int c_ = (U) >> 2, bb_ = ((U) & 3) * 2; \
        const unsigned short* p0_ = (const unsigned short*)(HYT + ((size_t)(0 * NB + bb_) * HYW + c_) * SEQ); const unsigned short* p1_ = (const unsigned short*)(HYT + ((size_t)(0 * NB + bb_ + 1) * HYW + c_) * SEQ); \
        _Pragma("unroll") for (int i = 0; i < 8; ++i) { nv0[i] = p0_[tid_ + NTHR * i]; nv1[i] = p1_[tid_ + NTHR * i]; } } while (0)
#define HY_ORDER(o, S, O) do { \
        const f32x2* K = SPEC + (size_t)((o) * HYW + c) * HYN2; \
        f32x2 kr[16]; \
        _Pragma("unroll") for (int i = 0; i < 8; ++i) { kr[2 * i] = K[tid + NTHR * i]; kr[2 * i + 1] = K[tid + NTHR * i + 4096]; } \
        const bf16_t* g0 = HYT + ((size_t)((1 + (o)) * NB + b0) * HYW + c) * SEQ; const bf16_t* g1 = HYT + ((size_t)((1 + (o)) * NB + b1) * HYW + c) * SEQ; \
        fft::pass16_pp<1, true>(S, O, tw2, tw31, tid); fft::pass16_pp<16>(O, S, tw2, tw31, tid); fft::pass16_pp<256>(S, O, tw2, tw31, tid); \
        f32x2 w = tw40; \
        _Pragma("unroll") for (int i = 0; i < 8; ++i) { const int j = tid + NTHR * i; if (i) w = (f32x2){w.x * 0.92387953251128674f + w.y * 0.38268343236508977f, w.y * 0.92387953251128674f - w.x * 0.38268343236508977f}; \
            const f32x2 a = O[pt + 544 * i], b = O[pt + 544 * i + 4352]; \
            const f32x2 bw = {b.x * w.x - b.y * w.y, b.x * w.y + b.y * w.x}; \
            const f32x2 z0 = a + bw, z1 = a - bw, k0 = kr[2 * i], k1 = kr[2 * i + 1]; \
            O[pt + 544 * i] = (f32x2){z0.x * k0.x - z0.y * k0.y, -(z0.x * k0.y + z0.y * k0.x)};             \
            O[pt + 544 * i + 4352] = (f32x2){z1.x * k1.x - z1.y * k1.y, -(z1.x * k1.y + z1.y * k1.x)}; } \
        __syncthreads(); \
        f32x2 gt[8]; \
        _Pragma("unroll") for (int i = 0; i < 8; ++i) { const int t = tid + NTHR * i; gt[i] = (f32x2){bf2f(g0[t]), bf2f(g1[t])}; } \
        if ((o) == 1 && unit + X.G < 4 * HYW) HY_LOADV(unit + X.G); \
        fft::pass16_pp<1>(O, S, tw2, tw31, tid); fft::pass16_pp<16>(S, O, tw2, tw31, tid); fft::pass16_pp<256>(O, S, tw2, tw31, tid); \
        const float bias = hb[(o) * HYW + c]; \
        w = tw40; \
        _Pragma("unroll") for (int i = 0; i < 8; ++i) { const int j = tid + NTHR * i; if (i) w = (f32x2){w.x * 0.92387953251128674f + w.y * 0.38268343236508977f, w.y * 0.92387953251128674f - w.x * 0.38268343236508977f}; \
            const f32x2 a = S[pt + 544 * i], b = S[pt + 544 * i + 4352]; \
            const f32x2 z = {a.x + (b.x * w.x - b.y * w.y), a.y + (b.x * w.y + b.y * w.x)}; \
            const float c0 = z.x * (1.f / HYN2), c1 = -z.y * (1.f / HYN2); \
            yc[i] = (f32x2){gt[i].x * (c0 + yc[i].x * bias), gt[i].y * (c1 + yc[i].y * bias)}; } } while (0)
    if (X.vcu < 4 * HYW) HY_LOADV(X.vcu);
    for (int unit = X.vcu; unit < 4 * HYW; unit += X.G) {
        int tid = X.tid; asm volatile("" : "+v"(tid));
        const int c = unit >> 2, b0 = (unit & 3) * 2, b1 = b0 + 1;
        const int pt = tid + (tid >> 4);
        f32x2 yc[8];
#pragma unroll
        for (int i = 0; i < 8; ++i) yc[i] = (f32x2){__uint_as_float((unsigned)nv0[i] << 16), __uint_as_float((unsigned)nv1[i] << 16)};
#pragma unroll
        for (int i = 0; i < 8; ++i) bufA[pt + 544 * i] = yc[i];
        __syncthreads();
        HY_ORDER(0, bufA, bufB);
#pragma unroll
        for (int i = 0; i < 8; ++i) bufB[pt + 544 * i] = yc[i];
        __syncthreads();
        HY_ORDER(1, bufB, bufA);
        {   bf16_t* o0 = HYO + ((size_t)b0 * HYW + c) * SEQ; bf16_t* o1 = HYO + ((size_t)b1 * HYW + c) * SEQ;
#pragma unroll
            for (int i = 0; i < 8; ++i) { const int t = tid + NTHR * i; o0[t] = f2bf(yc[i].x); o1[t] = f2bf(yc[i].y); } }
    }
#undef HY_ORDER
#undef HY_LOADV
    __syncthreads();
}
__device__ __forceinline__ void hyena_conv_ctx(const Ctx& X, int l) {
    const float* FILTC = (const float*)(X.ws + WS_FILTC); const bf16_t* HYTC = (const bf16_t*)(X.ws + WS_HYTC); bf16_t* HYOC = (bf16_t*)(X.ws + WS_HYOC);
    const float* hb = X.a->in[X.z + I_HBIAS] + l * 2 * HYW;
    const int half = X.tid >> 8, t = X.tid & 255;
    LAS f32x4* yv = (LAS f32x4*)X.lds;
    LAS float* kf = (LAS float*)(X.lds + 8192); LAS float* kb = kf + 256;
    for (int c = X.vcu; c < HYW; c += X.G) {
        f32x4 y;
#pragma unroll
        for (int q = 0; q < 4; ++q) y[q] = bf2f(HYTC[((size_t)(0 * NB + half * 4 + q) * HYW + c) * CTXL + t]);
#pragma unroll
        for (int o = 0; o < 2; ++o) {
            const float fv = FILTC[((size_t)(o * 2 + half) * HYW + c) * CTXL + t];
            unsigned short gr[4];
#pragma unroll
            for (int q = 0; q < 4; ++q) gr[q] = ((const unsigned short*)HYTC)[((size_t)((1 + o) * NB + half * 4 + q) * HYW + c) * CTXL + t];
            const float hbv = hb[o * HYW + c];
            asm volatile("" ::: "memory");
            __syncthreads();
            yv[half * 256 + t] = y;
            if (half == 0) kf[t] = fv; else kb[t] = fv;
            __syncthreads();
            f32x4 acc = {0.f, 0.f, 0.f, 0.f};
#pragma unroll 4
            for (int s = 0; s < CTXL; ++s) { const int lag = t - s; const float k = (lag >= 0) ? kf[lag] : kb[-lag]; acc += k * yv[half * 256 + s]; }
            f32x4 g;
#pragma unroll
            for (int q = 0; q < 4; ++q) g[q] = __uint_as_float((unsigned)gr[q] << 16);
            y = g * (acc + y * hbv);
        }
#pragma unroll
        for (int q = 0; q < 4; ++q) HYOC[((size_t)(half * 4 + q) * HYW + c) * CTXL + t] = f2bf(y[q]);
    }
    __syncthreads();
}

constexpr int NPH = 2 + 11 * NLAYER;
#ifndef PROBE_MASK
#define PROBE_MASK 0
#endif
#define NREP(k) (1 + ((PROBE_MASK >> (k)) & 1))
__global__ void __launch_bounds__(NTHR, 2) fwd(Args args) {
    extern __shared__ __attribute__((aligned(16))) unsigned char lds_raw[];
    Ctx X;
    X.a = &args; X.ws = args.ws; X.lds = (LAS unsigned char*)lds_raw;
    X.wave = __builtin_amdgcn_readfirstlane((int)threadIdx.x >> 6); X.tid = 0; X.lane = 0;
    X.G = gridDim.x; { const int bx = blockIdx.x; X.vcu = (X.G % 8 == 0) ? (bx % 8) * (X.G / 8) + bx / 8 : bx; }
    X.gw = X.vcu * NWAVES + X.wave; X.ngw = X.G * NWAVES; X.z = 0;
    volatile LAS unsigned* MISC = (volatile LAS unsigned*)(X.lds + LDS_MISC);
    if (threadIdx.x < 16) MISC[threadIdx.x] = 0u;
    __syncthreads();
    const int lo = args.ph_lo, hi = args.ph_hi;
    XcdBarrier bar; bar.bar = (unsigned*)(args.ws + WS_CTL) + CW_BAR + args.li * XCD_BAR_WORDS; bar.x = 0; bar.st = nullptr;
    if (hi - lo > 1) bar = xcd_barrier_post((unsigned*)(args.ws + WS_CTL) + CW_BAR + args.li * XCD_BAR_WORDS, MISC + 8);
#define IN(k) (lo <= (k) && (k) < hi)
#define SEAM(k) do { if (IN(k) && IN((k) + 1)) { for (int rb_ = 0; rb_ < NREP(22); ++rb_) xcd_barrier(bar, X.wave * 64 + lane_id(), (unsigned)X.G); } } while (0)

    if (IN(0)) { const Ctx Y = fresh(X); build_mod(Y); build_rope(Y); aux1_ktab(Y, 0, 0, 2 * S5G * 8, 0, Y.G); aux1_filt(Y, 0, 0, 256, 0); }
    SEAM(0);
    if (IN(1)) { const Ctx Y = fresh(X); build_modab(Y); aux2(Y, 0); aux2_spec(Y, 0, 0, HYW, 0); aux3(Y, 0); combine_norm(Y, 0); }
    SEAM(1);
    for (int l = 0; l < NLAYER; ++l) {
        const int pb = 2 + 11 * l;
        if (IN(pb + 0)) { for (int rep_ = 0; rep_ < NREP(0); ++rep_) {
            const Ctx Y = fresh(X); unsigned char* ws = Y.ws;
            const pg8::Gemm g{(const bf16_t*)(ws + WS_ACT), (const bf16_t*)(ws + WS_WIN), DM, DM, DM};
            const SchedRM S{7, 136 * 7, Y.G, Y.vcu, 0}; const EpiP E{(bf16_t*)(ws + WS_P), (bf16_t*)(ws + WS_UA), (float*)(ws + WS_SSQP)};
            pg8::gemm_phase<EpiP, SchedRM>(X.lds, g, S, E, X.wave);
            if (l + 1 < NLAYER) { const Ctx Y2 = fresh(X); aux1_ktab(Y2, l + 1, 0, 112, 184, 240); }
            if (l == 0) { const Ctx Y2 = fresh(X); aux1_filt(Y2, 0, 256, 68 * 4, 240); }
        } }
        SEAM(pb + 0);
        if (IN(pb + 1)) { for (int rep_ = 0; rep_ < NREP(1); ++rep_) {
            const Ctx Y0 = fresh(X); unsigned char* ws = Y0.ws;
            { const float* rope = (const float*)(ws + WS_ROPE); LAS float* rl = (LAS float*)(X.lds + 131072);
              const float r0 = rope[Y0.tid], r1 = rope[Y0.tid + NTHR]; rl[Y0.tid] = r0; rl[Y0.tid + NTHR] = r1; __syncthreads(); }
            { const pg8::Gemm g{(const bf16_t*)(ws + WS_UA), (const bf16_t*)(ws + WS_WMT), S5K, 1024, 1024};
              const SchedS5 S{1, 48, Y0.G, Y0.vcu, 0, 256}; const EpiS5A E{(float*)(ws + WS_S5S)};
              pg8::gemm_phase<EpiS5A, SchedS5>(X.lds, g, S, E, X.wave); }
            { const int cw = Y0.vcu - 48, cwr = (cw < 0) ? -1 : (cw + 8) % 208;
              { const pg8::Gemm g{(const bf16_t*)(ws + WS_P) + P_CQ, (const bf16_t*)(ws + WS_WUQ), PW, 384, 384};
                const SchedRMW S{3, 136 * 3, 208, cw, 0}; const EpiQ E{(bf16_t*)(ws + WS_Q), (const float*)(ws + WS_SSQP), (const LAS float*)(X.lds + 131072)};
                pg8::gemm_phase<EpiQ, SchedRMW>(X.lds, g, S, E, X.wave); }
              { const pg8::Gemm g{(const bf16_t*)(ws + WS_P) + P_CKV, (const bf16_t*)(ws + WS_WUKV), PW, 256, 256};
                const EpiKV E{(bf16_t*)(ws + WS_KV), (const float*)(ws + WS_SSQP)};
                const bool s5wg = Y0.vcu < 48;
                const SchedRMW S{4, s5wg ? 48 : 136 * 4, s5wg ? 48 : 208, s5wg ? Y0.vcu : cwr, s5wg ? 0 : 48}; pg8::gemm_phase<EpiKV, SchedRMW>(X.lds, g, S, E, X.wave); } }
            for (int r2_ = 0; r2_ < NREP(15); ++r2_) { const Ctx Y = fresh(X); kr_hyprep(Y, l); }
        } }
        SEAM(pb + 1);
        if (IN(pb + 2)) {
            { const Ctx Y = fresh(X); s5_scan(Y); }
            const Ctx Y1 = fresh(X); unsigned char* ws = Y1.ws;
            const bf16_t* Q = (const bf16_t*)(ws + WS_Q); const bf16_t* KV = (const bf16_t*)(ws + WS_KV); const bf16_t* KR = (const bf16_t*)(ws + WS_KR); bf16_t* O = (bf16_t*)(ws + WS_MLAO);
            __syncthreads();
            for (int rep_ = 0; rep_ < NREP(2); ++rep_)
            attn::attn_phase(Q, KV, KR, O, Y1.vcu, X.G, (LAS char*)X.lds, X.wave, l + 1 < NLAYER);
            for (int rep_ = 0; rep_ < NREP(12); ++rep_) { const Ctx Y = fresh(X); hyena_conv(Y, l); if (l + 1 < NLAYER) hyena_conv_ctx(Y, l); }
        }
        SEAM(pb + 2);
        if (IN(pb + 3)) { for (int rep_ = 0; rep_ < NREP(3); ++rep_) {
            const Ctx Y = fresh(X); unsigned char* ws = Y.ws;
            const pg8::Gemm g{(const bf16_t*)(ws + WS_UA), (const bf16_t*)(ws + WS_TMV), S5K, S5K, S5K};
            const SchedS5 S{4, 192, Y.G, Y.vcu, 0, 1024}; const EpiS5C E{(bf16_t*)(ws + WS_Y1)};
            pg8::gemm_phase<EpiS5C, SchedS5>(X.lds, g, S, E, X.wave);
            if (l + 1 < NLAYER) { const Ctx Y2 = fresh(X); aux1_filt(Y2, l + 1, 0, 64, 192); }
        } }
        SEAM(pb + 3);
        if (IN(pb + 4)) { for (int rep_ = 0; rep_ < NREP(4); ++rep_) {
            const Ctx Y = fresh(X); unsigned char* ws = Y.ws;
            const pg8::Gemm g{(const bf16_t*)(ws + WS_Y1), (const bf16_t*)(ws + WS_GLUW), 256, 256, 256};
            const SchedRM S{1, 136, Y.G, Y.vcu, 0}; const EpiGLU E{(const bf16_t*)(ws + WS_Y1), (bf16_t*)(ws + WS_S5O)};
            pg8::gemm_phase<EpiGLU, SchedRM>(X.lds, g, S, E, X.wave);
            if (l + 1 < NLAYER) { const Ctx Y2 = fresh(X); aux1_ktab(Y2, l + 1, 112, 2 * S5G * 8, 136, Y2.G); }
        } }
        SEAM(pb + 4);
        if (IN(pb + 5)) { for (int rep_ = 0; rep_ < NREP(5); ++rep_) { for (int r2_ = 0; r2_ < NREP(13); ++r2_) { const Ctx Y = fresh(X); merge_groups(Y, l, (l + 1 < NLAYER) ? TT : TL); } } }
        SEAM(pb + 5);
        if (IN(pb + 6)) {
            const Ctx Y = fresh(X); unsigned char* ws = Y.ws;
            const pg8::Gemm g{(const bf16_t*)(ws + WS_ACT), (const bf16_t*)(ws + WS_WOUT), DM, DM, DM};
            const SchedRM S{4, ((l + 1 < NLAYER) ? 136 : 128) * 4, Y.G, Y.vcu, 0};
            const float* rs0 = (l == 0) ? Y.a->in[Y.z + I_X] : (const float*)(ws + WS_XL); const float* rs1 = (l == 0) ? Y.a->in[Y.z + I_CTX] - (size_t)TL * DM : (const float*)(ws + WS_XL);
            const EpiOut E{(float*)(ws + WS_XL), (const float*)(ws + WS_MOD) + (size_t)l * 9 * 6144, (float*)(ws + WS_SSQP), rs0, rs1};
            pg8::gemm_phase<EpiOut, SchedRM>(X.lds, g, S, E, X.wave);
            for (int r2_ = 0; r2_ < NREP(19); ++r2_) if (l + 1 < NLAYER) { const Ctx Y2 = fresh(X); aux1_filt(Y2, l + 1, 64, 68 * 4, 32); }
            if (NREP(23) > 1) { const EpiDown E2{(bf16_t*)(ws + WS_GX)}; pg8::gemm_phase<EpiDown, SchedRM>(X.lds, g, S, E2, X.wave); }
        }
        SEAM(pb + 6);
        if (IN(pb + 7)) { for (int rep_ = 0; rep_ < NREP(7); ++rep_) { { const Ctx Y = fresh(X); norm2_router(Y, l, (l + 1 < NLAYER) ? 136 : 128); } for (int r2_ = 0; r2_ < NREP(18); ++r2_) { const Ctx Y = fresh(X); if (l + 1 < NLAYER) { aux2(Y, l + 1); aux2_spec(Y, l + 1, 0, HYW, 0); } } } }
        SEAM(pb + 7);
        if (IN(pb + 8)) { for (int rep_ = 0; rep_ < NREP(9); ++rep_) {
            const Ctx Y = fresh(X); unsigned char* ws = Y.ws;
            moe_table(Y, l);
            const pg8::Gemm g{(const bf16_t*)(ws + WS_ACT), (const bf16_t*)(ws + WS_W13), DM, DM, DM};
            const SchedMoE S{(const LAS int*)(X.lds + MT_OFF), Y.G, Y.vcu, true}; const EpiUp E{(bf16_t*)(ws + WS_HID)};
            pg8::gemm_phase<EpiUp, SchedMoE, true, true, true>(X.lds, g, S, E, X.wave, (const int*)(ws + WS_RTOK));
        } }
        SEAM(pb + 8);
        if (IN(pb + 9)) { for (int rep_ = 0; rep_ < NREP(10); ++rep_) {
            const Ctx Y = fresh(X); unsigned char* ws = Y.ws;
            if (hi - lo == 1) moe_table(Y, l);
            const pg8::Gemm g{(const bf16_t*)(ws + WS_HID), (const bf16_t*)(ws + WS_W2T), MOEH, MOEH, MOEH};
            const SchedMoE S{(const LAS int*)(X.lds + MT_OFF), Y.G, Y.vcu, false}; const EpiDown E{(bf16_t*)(ws + WS_GX)};
            pg8::gemm_phase<EpiDown, SchedMoE>(X.lds, g, S, E, X.wave);
        } }
        SEAM(pb + 9);
        if (IN(pb + 10)) { { const Ctx Y = fresh(X); if (hi - lo == 1) moe_table(Y, l); combine_norm(Y, l + 1); } for (int r2_ = 0; r2_ < NREP(21); ++r2_) { const Ctx Y = fresh(X); if (l + 1 < NLAYER) aux3(Y, l + 1); } }
        SEAM(pb + 10);
    }
#undef IN
#undef SEAM
}

#ifndef MK_CUTS
#define MK_CUTS 0
#endif
extern "C" void kernel_launch(void* const* d_in, const int* in_sizes, int n_in, void* d_out, int out_size, void* d_ws, size_t ws_size, hipStream_t stream) {
    static int grid = 0;
    if (grid == 0) {
        if (n_in != 40 || out_size != TL * DM || ws_size < WS_END) { fprintf(stderr, "kernel_launch: unexpected shapes: n_in %d out %d ws %zu (need %zu)\n", n_in, out_size, ws_size, (size_t)WS_END); grid = -1; return; }
        int dev = 0, cus = 0;
        if (hipGetDevice(&dev) != hipSuccess || hipDeviceGetAttribute(&cus, hipDeviceAttributeMultiprocessorCount, dev) != hipSuccess) { grid = -1; return; }
        if (hipFuncSetAttribute((const void*)fwd, hipFuncAttributeMaxDynamicSharedMemorySize, LDS_BYTES) != hipSuccess) { fprintf(stderr, "kernel_launch: hipFuncSetAttribute failed\n"); grid = -1; return; }
        int per_cu = 0;
        if (hipOccupancyMaxActiveBlocksPerMultiprocessor(&per_cu, (const void*)fwd, NTHR, LDS_BYTES) != hipSuccess || per_cu < 1) { fprintf(stderr, "kernel_launch: occupancy query says %d\n", per_cu); }
        (void)hipGetLastError();
        grid = cus;
    }
    if (grid < 0) return;
    (void)hipMemsetAsync(d_ws, 0, ZERO_BYTES, stream);
    Args a{};
    for (int i = 0; i < 40; ++i) a.in[i] = (const float*)d_in[i];
    a.out = (float*)d_out; a.ws = (unsigned char*)d_ws; a.pad = 0;
#if MK_CUTS
    for (int p = 0; p < NPH; ++p) { a.ph_lo = p; a.ph_hi = p + 1; a.li = p; hipLaunchKernelGGL(fwd, dim3(grid), dim3(NTHR), LDS_BYTES, stream, a); }
#else
    a.ph_lo = 0; a.ph_hi = NPH; a.li = 0; hipLaunchKernelGGL(fwd, dim3(grid), dim3(NTHR), LDS_BYTES, stream, a);
#endif
}
```

```cpp
#include <hip/hip_runtime.h>
#include <cstdio>
#include <cstdint>

#define LAS __attribute__((address_space(3)))
#define GAS __attribute__((address_space(1)))
typedef unsigned short bf16_t;
typedef short bf16x8 __attribute__((ext_vector_type(8)));
typedef short s16x4 __attribute__((ext_vector_type(4)));
typedef float f32x4 __attribute__((ext_vector_type(4)));
typedef float f32x2 __attribute__((ext_vector_type(2)));
typedef float f32x16 __attribute__((ext_vector_type(16)));
typedef unsigned u32x4 __attribute__((ext_vector_type(4)));
typedef unsigned u32x2 __attribute__((ext_vector_type(2)));

constexpr int DM = 1024, NB = 8, SEQ = 4096, NLAYER = 4, CTXL = 256;
constexpr int TL = NB * SEQ;
constexpr int TC = NB * CTXL;
constexpr int TT = TL + TC;
constexpr int PW = 1792;
constexpr int P_U = 0, P_CQ = 256, P_CKV = 640, P_KR = 896, P_HZ = 928, P_IN = 1696;
constexpr int NHEAD = 8, DQK = 96, DV = 64, QW = NHEAD * DQK  , KVW = NHEAD * 128  ;
constexpr int NKEY = CTXL + SEQ;
constexpr int S5G = 16, S5H = 16, S5P = 64, S5LC = 64, S5NCH = NKEY / S5LC  , S5ROWS = NB * S5NCH  , S5ROWSP = 768, S5K = 1280;
constexpr int HYW = 256, HYN2 = 8192;
constexpr int NEXP = 32, MOEH = 512, MOE_MAXTILES = 304, MOE_MAXROWS = MOE_MAXTILES * 256;
constexpr float EPS = 1e-6f;
constexpr int NWAVES = 8, NTHR = 512;

#define LDS_WAIT() asm volatile("s_waitcnt lgkmcnt(0)" ::: "memory")
#define VM_WAIT() asm volatile("s_waitcnt vmcnt(0)" ::: "memory")
__device__ __forceinline__ unsigned cvt_pk_bf16(float lo, float hi) { unsigned r; asm volatile("v_cvt_pk_bf16_f32 %0, %1, %2" : "=v"(r) : "v"(lo), "v"(hi)); return r; }
__device__ __forceinline__ float bf2f(unsigned short h) { return __uint_as_float(((unsigned)h) << 16); }
__device__ __forceinline__ float bflo(unsigned w) { return __uint_as_float(w << 16); }
__device__ __forceinline__ float bfhi(unsigned w) { return __uint_as_float(w & 0xffff0000u); }
__device__ __forceinline__ unsigned short f2bf(float f) { return (unsigned short)(cvt_pk_bf16(f, 0.f) & 0xffffu); }
__device__ __forceinline__ float wave_sum(float v) {
#pragma unroll
    for (int o = 1; o < 64; o <<= 1) v += __shfl_xor(v, o);
    return v;
}
__device__ __forceinline__ float fast_exp(float x) { return __builtin_amdgcn_exp2f(x * 1.4426950408889634f); }
__device__ __forceinline__ float sigmoidf_(float x) { return __builtin_amdgcn_rcpf(1.f + fast_exp(-x)); }
__device__ __forceinline__ float siluf_(float x) { return x * sigmoidf_(x); }
__device__ __forceinline__ float gelu_tanh(float x) {
    const float z = 0.7978845608028654f * (x + 0.044715f * x * x * x);
    const float t = 1.f - 2.f * __builtin_amdgcn_rcpf(1.f + fast_exp(2.f * z));
    return 0.5f * x * (1.f + t);
}
__device__ __forceinline__ void sincos_rev(float r, float& s, float& c) { r = r - rintf(r); s = __builtin_amdgcn_sinf(r); c = __builtin_amdgcn_cosf(r); }
__device__ __forceinline__ void sincos_rad(float a, float& s, float& c) { sincos_rev(a * 0.15915494309189535f, s, c); }
__device__ __forceinline__ void sincos_rad_d(double a, float& s, float& c) { double r = a * 0.15915494309189533577; r = r - __builtin_rint(r); s = __builtin_amdgcn_sinf((float)r); c = __builtin_amdgcn_cosf((float)r); }

__device__ __forceinline__ int lane_id() { int l; asm volatile("v_mbcnt_lo_u32_b32 %0, -1, 0\n\tv_mbcnt_hi_u32_b32 %0, -1, %0" : "=&v"(l)); return l; }

#define XB_TMO      128
#define XB_XCNT(j)  (256  + 64 * (j))
#define XB_XSUB(j)  (1280 + 64 * (j))
#define XB_XGEN(j)  (2304 + 64 * (j))
#define XB_TOP      3328
#define XB_TOPGEN   3392
#define XCD_BAR_WORDS 3456
#define XB_SPIN_CAP (1u << 18)
__device__ __forceinline__ unsigned xb_ld(unsigned* p)              { return __hip_atomic_load(p, __ATOMIC_RELAXED, __HIP_MEMORY_SCOPE_AGENT); }
__device__ __forceinline__ unsigned xb_add(unsigned* p, unsigned v) { return __hip_atomic_fetch_add(p, v, __ATOMIC_RELAXED, __HIP_MEMORY_SCOPE_AGENT); }
__device__ __forceinline__ unsigned xb_xcc_id() { return (unsigned)__builtin_amdgcn_s_getreg((3 << 11) | 20) & 0xFu; }
#define XB_SPIN(cond, bar) do { unsigned _sp = 0; while (cond) { __builtin_amdgcn_s_sleep(1); \
    if ((++_sp & 255u) == 0u) { if (xb_ld(&(bar)[XB_TMO])) break; if (_sp > XB_SPIN_CAP) { atomicAdd(&(bar)[XB_TMO], 1u); break; } } } } while (0)
struct XcdBarrier { unsigned* bar; unsigned x; volatile LAS unsigned* st; };
__device__ __forceinline__ XcdBarrier xcd_barrier_post(unsigned* bar, volatile LAS unsigned* st) {
    XcdBarrier b; b.bar = bar; b.x = xb_xcc_id(); b.st = st;
    if (threadIdx.x == 0) (void)xb_add(&bar[XB_XCNT(b.x)], 1u);
    return b;
}
__device__ __forceinline__ void xcd_barrier_complete(unsigned* bar, unsigned x, unsigned& nloc, unsigned& nx, const unsigned G) {
    unsigned sum, cnt, mine, sp = 0u;
    for (;;) {
        sum = 0u; cnt = 0u; mine = 0u;
#pragma unroll
        for (unsigned j = 0; j < 16; ++j) { const unsigned c = xb_ld(&bar[XB_XCNT(j)]); sum += c; cnt += (c > 0u) ? 1u : 0u; mine = (j == x) ? c : mine; }
        if (sum == G) break;
        __builtin_amdgcn_s_sleep(1);
        if ((++sp & 255u) == 0u) { if (xb_ld(&bar[XB_TMO])) break; if (sp > XB_SPIN_CAP) { atomicAdd(&bar[XB_TMO], 1u); break; } }
    }
    nloc = mine > 0u ? mine : 1u; nx = cnt > 0u ? cnt : 1u;
}
__device__ __noinline__ void xcd_barrier_f(unsigned* bar_, unsigned bx_, volatile LAS unsigned* st_, int tid_, unsigned G_) {
    XcdBarrier b; b.bar = bar_; b.x = bx_; b.st = st_;
    asm volatile("s_waitcnt vmcnt(0)" ::: "memory");
    __syncthreads();
    if (tid_ == 0) {
        unsigned* bar = b.bar;
        __builtin_amdgcn_s_waitcnt(0);
        unsigned nloc = b.st[0], nx = b.st[1];
        if (nloc == 0u) { xcd_barrier_complete(bar, b.x, nloc, nx, G_); b.st[0] = nloc; b.st[1] = nx; }
        const unsigned old = xb_add(&bar[XB_XSUB(b.x)], 1u);
        const unsigned gen = old / nloc;
        if (old + 1u == (gen + 1u) * nloc) {
            __builtin_amdgcn_fence(__ATOMIC_RELEASE, "agent");
            asm volatile("s_waitcnt vmcnt(0)" ::: "memory");
            const unsigned og = xb_add(&bar[XB_TOP], 1u);
            const unsigned tg = og / nx;
            if (og + 1u == (tg + 1u) * nx) xb_add(&bar[XB_TOPGEN], 1u);
            else XB_SPIN(xb_ld(&bar[XB_TOPGEN]) == tg, bar);
            __builtin_amdgcn_fence(__ATOMIC_ACQUIRE, "agent");
            xb_add(&bar[XB_XGEN(b.x)], 1u);
            asm volatile("s_waitcnt vmcnt(0)" ::: "memory");
        } else {
            XB_SPIN(xb_ld(&bar[XB_XGEN(b.x)]) == gen, bar);
            __builtin_amdgcn_fence(__ATOMIC_ACQUIRE, "agent");
            asm volatile("s_waitcnt vmcnt(0)" ::: "memory");
        }
    }
    __syncthreads();
}
__device__ __forceinline__ void xcd_barrier(const XcdBarrier& b, int tid, unsigned G) { xcd_barrier_f(b.bar, b.x, b.st, tid, G); }
__device__ __noinline__ void xcd_arrive_f(unsigned* bar_, unsigned bx_, volatile LAS unsigned* st_, int tid_, unsigned G_) {
    asm volatile("s_waitcnt vmcnt(0)" ::: "memory");
    __syncthreads();
    if (tid_ == 0) {
        __builtin_amdgcn_s_waitcnt(0);
        unsigned nloc = st_[0], nx = st_[1];
        if (nloc == 0u) { xcd_barrier_complete(bar_, bx_, nloc, nx, G_); st_[0] = nloc; st_[1] = nx; }
        const unsigned old = xb_add(&bar_[XB_XSUB(bx_)], 1u);
        const unsigned gen = old / nloc;
        st_[2] = gen; st_[3] = (old + 1u == (gen + 1u) * nloc) ? 1u : 0u;
    }
    __syncthreads();
}
__device__ __noinline__ void xcd_wait_f(unsigned* bar_, unsigned bx_, volatile LAS unsigned* st_, int tid_) {
    asm volatile("s_waitcnt vmcnt(0)" ::: "memory");
    __syncthreads();
    if (tid_ == 0) {
        unsigned* bar = bar_;
        __builtin_amdgcn_s_waitcnt(0);
        const unsigned nx = st_[1], gen = st_[2], last = st_[3];
        if (last) {
            __builtin_amdgcn_fence(__ATOMIC_RELEASE, "agent");
            asm volatile("s_waitcnt vmcnt(0)" ::: "memory");
            const unsigned og = xb_add(&bar[XB_TOP], 1u);
            const unsigned tg = og / nx;
            if (og + 1u == (tg + 1u) * nx) xb_add(&bar[XB_TOPGEN], 1u);
            else XB_SPIN(xb_ld(&bar[XB_TOPGEN]) == tg, bar);
            __builtin_amdgcn_fence(__ATOMIC_ACQUIRE, "agent");
            xb_add(&bar[XB_XGEN(bx_)], 1u);
            asm volatile("s_waitcnt vmcnt(0)" ::: "memory");
        } else {
            XB_SPIN(xb_ld(&bar[XB_XGEN(bx_)]) == gen, bar);
            __builtin_amdgcn_fence(__ATOMIC_ACQUIRE, "agent");
            asm volatile("s_waitcnt vmcnt(0)" ::: "memory");
        }
    }
    __syncthreads();
}

namespace pg8 {
constexpr int BM = 256, BK = 64, HALF = 128, HTB = HALF * BK * 2, STAGE_BYTES = 8 * HTB;
__host__ __device__ __forceinline__ int lds_byte(int r, int c) { const int st = (r >> 4) * 2 + (c >> 5), rr = r & 15, cc = c & 31, ob = rr * 64 + cc * 2; return st * 1024 + (ob ^ (((ob >> 9) & 1) << 5)); }
__host__ __device__ __forceinline__ void stage_rc(int b, int& R, int& C) { const int st = b / 1024, sb = b % 1024, swz = sb ^ (((sb >> 9) & 1) << 5); R = (st >> 1) * 16 + swz / 64; C = (st & 1) * 32 + (swz % 64) / 2; }
__host__ __device__ __forceinline__ int perm32(int rho) { const int n = rho >> 4, i = rho & 15; return 8 * (i >> 2) + 4 * n + (i & 3); }

struct Unit { int pm, pn, arow, brow, aux, nval; };
struct Gemm { const bf16_t* A; const bf16_t* Bt; int lda, ldb, K; };

template <class Epi, class Sched, bool ALIGN_EPI = true, bool SP2 = true, bool GATHER = false>
__device__ __forceinline__ void gemm_phase(LAS unsigned char* lds, const Gemm g, const Sched& S, const Epi& E, int wave_, const int* rowidx = nullptr) {
    static_assert(SP2 || !GATHER, "GATHER is implemented for the SP2 loop only");
    int tid_ = wave_ * 64 + lane_id(); asm volatile("" : "+v"(tid_));
    const int tid = tid_, wid = __builtin_amdgcn_readfirstlane(tid >> 6), lane = tid & 63, wr = wid >> 2, wc = wid & 3, fr = lane & 15, fq = lane >> 4;
    int K_ = g.K; asm volatile("" : "+s"(K_));
    const int K = K_, nt = K / BK;
    unsigned voffA[2], voffB[2]; int sR[2]; unsigned sC2[2];
#pragma unroll
    for (int i = 0; i < 2; ++i) { int R, C; stage_rc(tid * 16 + i * 8192, R, C); const int Rb = Epi::PERM ? ((R & ~31) + perm32(R & 31)) : R; sR[i] = R; sC2[i] = (unsigned)C * 2u;
        voffA[i] = (unsigned)(R * g.lda + C) * 2u; voffB[i] = (unsigned)(Rb * g.ldb + C) * 2u; }
    const size_t kstep = (size_t)(BK * 2);
    const size_t hstepA = (size_t)HALF * g.lda * 2, hstepB = (size_t)HALF * g.ldb * 2;
    unsigned cvA0[2], cvA1[2], nvA0[2], nvA1[2];
#define PG8_AOFFS(dst0, dst1, un_) do { _Pragma("unroll") for (int _i = 0; _i < 2; ++_i) { \
        if constexpr (GATHER) { const int _r0 = sR[_i], _r1 = HALF + sR[_i];            \
            const int _c0 = (_r0 < (un_).nval) ? _r0 : (un_).nval - 1, _c1 = (_r1 < (un_).nval) ? _r1 : (un_).nval - 1;     \
            const unsigned _x0 = (unsigned)rowidx[(un_).arow + _c0], _x1 = (unsigned)rowidx[(un_).arow + _c1]; \
            dst0[_i] = _x0 * (unsigned)(g.lda * 2) + sC2[_i]; dst1[_i] = _x1 * (unsigned)(g.lda * 2) + sC2[_i]; } \
        else { dst0[_i] = voffA[_i]; dst1[_i] = voffA[_i] + (unsigned)hstepA; } } } while (0)
    const unsigned ldsw = (unsigned)wid * 1024u;
    const int aoff = lds_byte(wr * 64 + fr, fq * 8), boff = lds_byte(wc * 32 + fr, fq * 8);
#define PG8_SA(b, h) (((b) * 2 + (h)) * HTB)
#define PG8_SB(b, h) ((4 + (b) * 2 + (h)) * HTB)
#define PG8_STAGE(bufoff, gbase, voff) do { _Pragma("unroll") for (int _i = 0; _i < 2; ++_i) \
        __builtin_amdgcn_global_load_lds((const unsigned*)((const char*)(gbase) + (voff)[_i]), (LAS unsigned*)(lds + (bufoff) + ldsw + _i * 8192), 16, 0, 0); } while (0)
#define PG8_LDA(dst, b, h) do { _Pragma("unroll") for (int m = 0; m < 4; ++m) _Pragma("unroll") for (int k = 0; k < 2; ++k) dst[m][k] = *(const LAS bf16x8*)(lds + PG8_SA(b, h) + aoff + m * 2048 + k * 1024); } while (0)
#define PG8_LDB(dst, b, h) do { _Pragma("unroll") for (int n = 0; n < 2; ++n) _Pragma("unroll") for (int k = 0; k < 2; ++k) dst[n][k] = *(const LAS bf16x8*)(lds + PG8_SB(b, h) + boff + n * 2048 + k * 1024); } while (0)
#define PG8_MMA(ai, bj, At, Bt) do { __builtin_amdgcn_s_setprio(1); _Pragma("unroll") for (int m = 0; m < 4; ++m) _Pragma("unroll") for (int n = 0; n < 2; ++n) _Pragma("unroll") for (int k = 0; k < 2; ++k) \
        acc[ai][bj][m][n] = __builtin_amdgcn_mfma_f32_16x16x32_bf16(Bt[n][k], At[m][k], acc[ai][bj][m][n], 0, 0, 0); __builtin_amdgcn_s_setprio(0); } while (0)
#define PG8_WAIT_V(n) asm volatile("s_waitcnt vmcnt(" #n ")" ::: "memory")
#define PG8_WAIT_L(n) asm volatile("s_waitcnt lgkmcnt(" #n ")" ::: "memory")
#define PG8_BAR __builtin_amdgcn_s_barrier()
#define PG8_SCHED __builtin_amdgcn_sched_barrier(0)
    Unit cur, nxt; int ui = 0;
    if (!S.next(0, cur)) return;
    f32x4 acc[2][2][4][2];
#pragma unroll
    for (int a = 0; a < 2; ++a)
#pragma unroll
        for (int b = 0; b < 2; ++b)
#pragma unroll
            for (int m = 0; m < 4; ++m)
#pragma unroll
                for (int n = 0; n < 2; ++n) acc[a][b][m][n] = (f32x4){0.f, 0.f, 0.f, 0.f};
    bf16x8 At[4][2], B0[2][2], B1[2][2];
    const char* cA = GATHER ? (const char*)g.A : (const char*)g.A + (size_t)cur.arow * g.lda * 2; const char* cB = (const char*)g.Bt + (size_t)cur.brow * g.ldb * 2;
    PG8_AOFFS(cvA0, cvA1, cur);
    if constexpr (SP2) {
        PG8_STAGE(PG8_SB(0, 0), cB, voffB); PG8_STAGE(PG8_SB(0, 1), cB + hstepB, voffB); PG8_STAGE(PG8_SA(0, 0), cA, cvA0); PG8_STAGE(PG8_SA(0, 1), cA, cvA1);
        if (wr == 1) PG8_BAR;
        PG8_WAIT_V(2); PG8_BAR;
        PG8_STAGE(PG8_SB(1, 0), cB + kstep, voffB); PG8_STAGE(PG8_SA(1, 0), cA + kstep, cvA0); PG8_STAGE(PG8_SB(1, 1), cB + hstepB + kstep, voffB);
        PG8_WAIT_V(6); PG8_BAR;
    } else {
        PG8_STAGE(PG8_SB(0, 0), cB, voffB); PG8_STAGE(PG8_SA(0, 0), cA, voffA); PG8_STAGE(PG8_SB(0, 1), cB + hstepB, voffB); PG8_STAGE(PG8_SA(0, 1), cA + hstepA, voffA);
        if (wr == 1) PG8_BAR;
        PG8_WAIT_V(4); PG8_BAR;
        PG8_STAGE(PG8_SB(1, 0), cB + kstep, voffB); PG8_STAGE(PG8_SA(1, 0), cA + kstep, voffA); PG8_STAGE(PG8_SB(1, 1), cB + hstepB + kstep, voffB);
        PG8_WAIT_V(6); PG8_BAR;
    }
    for (;;) {
        const bool has_next = S.next(ui + 1, nxt);
        const char* nA = (has_next && !GATHER) ? (const char*)g.A + (size_t)nxt.arow * g.lda * 2 : cA; const char* nB = has_next ? (const char*)g.Bt + (size_t)nxt.brow * g.ldb * 2 : cB;
        if (GATHER && has_next) PG8_AOFFS(nvA0, nvA1, nxt);
        else { _Pragma("unroll") for (int _i = 0; _i < 2; ++_i) { nvA0[_i] = cvA0[_i]; nvA1[_i] = cvA1[_i]; } }
        for (int t = 0; t < nt; t += 2) {
            const bool last = (t == nt - 2);
            const char* a1 = cA + (size_t)(t + 1) * kstep;
            const char* a2 = last ? nA : cA + (size_t)(t + 2) * kstep; const char* b2 = last ? nB : cB + (size_t)(t + 2) * kstep;
            const char* a3 = a2 + kstep; const char* b3 = b2 + kstep;
            if constexpr (SP2) {
            unsigned xA0[2], xA1[2];
#pragma unroll
            for (int _i = 0; _i < 2; ++_i) { xA0[_i] = last ? nvA0[_i] : cvA0[_i]; xA1[_i] = last ? nvA1[_i] : cvA1[_i]; }
            PG8_LDB(B0, 0, 0); PG8_LDB(B1, 0, 1); PG8_SCHED; PG8_LDA(At, 0, 0); PG8_STAGE(PG8_SA(1, 1), a1, cvA1);
            PG8_WAIT_V(8); PG8_WAIT_L(0); PG8_BAR; PG8_MMA(0, 0, At, B0); PG8_MMA(0, 1, At, B1); PG8_BAR; PG8_SCHED;
            PG8_LDA(At, 0, 1); PG8_STAGE(PG8_SB(0, 0), b2, voffB); PG8_STAGE(PG8_SB(0, 1), b2 + hstepB, voffB); PG8_STAGE(PG8_SA(0, 0), a2, xA0);
            PG8_WAIT_V(8); PG8_WAIT_L(0); PG8_BAR; PG8_MMA(1, 0, At, B0); PG8_MMA(1, 1, At, B1); PG8_BAR; PG8_SCHED;
            PG8_LDB(B0, 1, 0); PG8_LDB(B1, 1, 1); PG8_SCHED; PG8_LDA(At, 1, 0); PG8_STAGE(PG8_SA(0, 1), a2, xA1);
            PG8_WAIT_V(8); PG8_WAIT_L(0); PG8_BAR; PG8_MMA(0, 0, At, B0); PG8_MMA(0, 1, At, B1); PG8_BAR; PG8_SCHED;
            PG8_LDA(At, 1, 1); PG8_STAGE(PG8_SB(1, 0), b3, voffB); PG8_STAGE(PG8_SB(1, 1), b3 + hstepB, voffB); PG8_STAGE(PG8_SA(1, 0), a3, xA0);
            PG8_WAIT_V(8); PG8_WAIT_L(0); PG8_BAR; PG8_MMA(1, 0, At, B0); PG8_MMA(1, 1, At, B1); PG8_BAR; PG8_SCHED;
            } else {
            PG8_LDB(B0, 0, 0); PG8_SCHED; PG8_LDA(At, 0, 0); PG8_STAGE(PG8_SA(1, 1), a1 + hstepA, voffA);
            PG8_WAIT_L(8); PG8_BAR; PG8_WAIT_L(0); PG8_MMA(0, 0, At, B0); PG8_BAR; PG8_SCHED;
            PG8_LDB(B1, 0, 1); PG8_STAGE(PG8_SB(0, 0), b2, voffB);
            PG8_BAR; PG8_WAIT_L(0); PG8_MMA(0, 1, At, B1); PG8_BAR;
            PG8_LDA(At, 0, 1); PG8_STAGE(PG8_SA(0, 0), a2, voffA);
            PG8_BAR; PG8_WAIT_L(0); PG8_MMA(1, 0, At, B0); PG8_BAR; PG8_SCHED;
            PG8_STAGE(PG8_SB(0, 1), b2 + hstepB, voffB);
            PG8_WAIT_V(6); PG8_BAR; PG8_MMA(1, 1, At, B1); PG8_BAR;
            PG8_LDB(B0, 1, 0); PG8_SCHED; PG8_LDA(At, 1, 0); PG8_STAGE(PG8_SA(0, 1), a2 + hstepA, voffA);
            PG8_WAIT_L(8); PG8_BAR; PG8_WAIT_L(0); PG8_MMA(0, 0, At, B0); PG8_BAR; PG8_SCHED;
            PG8_LDB(B1, 1, 1); PG8_STAGE(PG8_SB(1, 0), b3, voffB);
            PG8_BAR; PG8_WAIT_L(0); PG8_MMA(0, 1, At, B1); PG8_BAR;
            PG8_LDA(At, 1, 1); PG8_STAGE(PG8_SA(1, 0), a3, voffA);
            PG8_BAR; PG8_WAIT_L(0); PG8_MMA(1, 0, At, B0); PG8_BAR; PG8_SCHED;
            PG8_STAGE(PG8_SB(1, 1), b3 + hstepB, voffB);
            PG8_WAIT_V(6); PG8_BAR; PG8_MMA(1, 1, At, B1); PG8_BAR;
            }
        }
        if constexpr (ALIGN_EPI) { if (wr == 0) PG8_BAR; }
        E(acc, cur, wr, wc, fr, fq);
        if (!has_next) break;
        float zf = 0.f; asm volatile("" : "+v"(zf));
#pragma unroll
        for (int a = 0; a < 2; ++a)
#pragma unroll
            for (int b = 0; b < 2; ++b)
#pragma unroll
                for (int m = 0; m < 4; ++m)
#pragma unroll
                    for (int n = 0; n < 2; ++n) acc[a][b][m][n] = (f32x4){zf, zf, zf, zf};
        cur = nxt; cA = nA; cB = nB; ++ui;
#pragma unroll
        for (int _i = 0; _i < 2; ++_i) { cvA0[_i] = nvA0[_i]; cvA1[_i] = nvA1[_i]; }
        if constexpr (ALIGN_EPI) { if (wr == 1) PG8_BAR; }
    }
    PG8_WAIT_V(0);
    if constexpr (!ALIGN_EPI) { if (wr == 0) PG8_BAR; }
    PG8_BAR;
#undef PG8_SA
#undef PG8_AOFFS
#undef PG8_SB
#undef PG8_STAGE
#undef PG8_LDA
#undef PG8_LDB
#undef PG8_MMA
#undef PG8_WAIT_V
#undef PG8_WAIT_L
#undef PG8_BAR
#undef PG8_SCHED
}
}

constexpr size_t al256(size_t x) { return (x + 255) & ~(size_t)255; }
constexpr size_t WS_CTL = 0;
constexpr size_t WS_MOD = 1u << 20;
constexpr size_t ZERO_BYTES = 2u << 20;
constexpr size_t WS_XL   = ZERO_BYTES;
constexpr size_t WS_ACT  = WS_XL + (size_t)TT * DM * 4;
constexpr size_t WS_SSQP = WS_ACT + (size_t)TT * DM * 2;
constexpr size_t WS_EID  = WS_SSQP + (size_t)TT * 32 * 4;
constexpr size_t WS_GATE = WS_EID + (size_t)TT * 8;
constexpr size_t WS_SLOT = WS_GATE + (size_t)TT * 8;
constexpr size_t WS_HIST = WS_SLOT + (size_t)TT * 8;
constexpr size_t WS_BLKE = WS_HIST + 256 * 32 * 4;
constexpr size_t WS_ROPE = WS_BLKE + 512 * 4;
constexpr int MOE_CAP = TT * 2;
constexpr size_t WS_RTOK = al256(WS_ROPE + 64 * 8 * 2 * 4);
constexpr size_t WS_MIX  = al256(WS_RTOK + (size_t)NEXP * MOE_CAP * 4);
constexpr int CW_ECNT = 200000;
constexpr size_t WS_P    = WS_MIX;
constexpr size_t WS_Q    = WS_P + (size_t)TT * PW * 2;
constexpr size_t WS_KV   = WS_Q + (size_t)TT * QW * 2;
constexpr size_t WS_KR   = WS_KV + (size_t)TT * KVW * 2;
constexpr size_t WS_UA   = WS_KR + (size_t)TT * 32 * 2;
constexpr size_t WS_S5S  = WS_UA + (size_t)S5G * S5ROWSP * S5K * 2;
constexpr size_t WS_Y1   = WS_S5S + (size_t)S5G * S5ROWSP * 256 * 4;
constexpr size_t WS_S5O  = WS_Y1 + (size_t)TT * 256 * 2;
constexpr size_t WS_MLAO = WS_S5O + (size_t)TT * 256 * 2;
constexpr size_t WS_HYT  = WS_MLAO + (size_t)TT * 512 * 2;
constexpr size_t WS_HYTC = WS_HYT + (size_t)3 * NB * HYW * SEQ * 2;
constexpr size_t WS_HYO  = WS_HYTC + (size_t)3 * NB * HYW * CTXL * 2;
constexpr size_t WS_HYOC = WS_HYO + (size_t)NB * HYW * SEQ * 2;
constexpr size_t WS_MIXEND = WS_HYOC + (size_t)NB * HYW * CTXL * 2;
constexpr size_t WS_GX   = WS_MIX;
constexpr size_t WS_HID  = WS_GX + (size_t)MOE_MAXROWS * DM * 2;
static_assert(WS_HID + (size_t)MOE_MAXROWS * MOEH * 2 <= WS_MIXEND, "MoE overlay fits");
constexpr size_t WS_WIN  = al256(WS_MIXEND);
constexpr size_t WS_WUQ  = WS_WIN + (size_t)PW * DM * 2;
constexpr size_t WS_WUKV = WS_WUQ + (size_t)QW * 384 * 2;
constexpr size_t WS_WOUT = WS_WUKV + (size_t)KVW * 256 * 2;
constexpr size_t WS_GLUW = WS_WOUT + (size_t)DM * DM * 2;
constexpr size_t WS_W13  = WS_GLUW + (size_t)256 * 256 * 2;
constexpr size_t WS_W2T  = WS_W13 + (size_t)NEXP * 1024 * DM * 2;
constexpr size_t WS_TMV  = WS_W2T + (size_t)NEXP * DM * MOEH * 2;
constexpr size_t WS_WMT  = WS_TMV + (size_t)S5G * 1024 * S5K * 2;
constexpr size_t WS_LAML = WS_WMT + (size_t)S5G * 256 * 1024 * 2;
constexpr size_t WS_KTAB = WS_LAML + (size_t)2 * S5G * S5P * 2 * 4;
constexpr size_t WS_FILT = WS_KTAB + (size_t)2 * S5G * S5LC * 256 * 4;
constexpr size_t WS_FILTC= WS_FILT + (size_t)2 * HYW * HYN2 * 4;
constexpr size_t WS_SPEC = WS_FILTC + (size_t)2 * 2 * HYW * CTXL * 4;
constexpr size_t WS_MODAB = WS_SPEC + (size_t)2 * HYW * HYN2 * 8;
constexpr size_t WS_END  = WS_MODAB + (size_t)NLAYER * 9 * 4 * DM * 4;
constexpr int CW_BAR = 4096;

constexpr int LDS_BYTES = 156672;
constexpr int LDS_MISC = 155648;

struct Args { const float* in[40]; float* out; unsigned char* ws; int ph_lo, ph_hi, li, pad; };
enum { I_X = 0, I_C, I_CTX, I_CCTX, I_ADAW, I_ADAB, I_N1G, I_N2G, I_WIN, I_LRE, I_LIM, I_LDT, I_BRE, I_BIM, I_CRE, I_CIM, I_S5D, I_GLU, I_QNG, I_KVNG, I_WUQ, I_WUKV,
       I_HSW, I_HSB, I_FW1, I_FB1, I_FW2, I_FB2, I_FW3, I_FB3, I_FFQ, I_HBIAS, I_MIXG, I_WOUT, I_WGRP, I_WEXP, I_W1, I_W3, I_W2, I_FING };

struct Ctx {
    const Args* a; unsigned char* ws; LAS unsigned char* lds;
    int tid, lane, wave, vcu, G, gw, ngw, z;
};
__device__ __forceinline__ Ctx fresh(const Ctx& X) { Ctx Y = X; { GAS unsigned char* gp = (GAS unsigned char*)X.ws; asm volatile("" : "+s"(gp)); Y.ws = (unsigned char*)gp; }
    int w = Y.wave; asm volatile("" : "+s"(w)); Y.wave = w; Y.lane = lane_id(); asm volatile("" : "+v"(Y.lane)); Y.tid = w * 64 + Y.lane; int v = Y.vcu; asm volatile("" : "+s"(v)); Y.vcu = v; Y.gw = v * NWAVES + w; int z = 0; asm volatile("" : "+s"(z)); Y.z = z; return Y; }
__device__ __forceinline__ int row_b(int row) { return row < TL ? (row >> 12) : 8; }

struct SchedRM {
    int nN, total, G, c, off;
    __device__ __forceinline__ bool next(int i, pg8::Unit& u) const {
        const int L = i * G + ((c + G - off) % G); if (L >= total) return false;
        u.pm = L / nN; u.pn = L % nN; u.arow = u.pm * 256; u.brow = u.pn * 256; u.aux = 0; u.nval = 256; return true; }
};
struct SchedRMW {
    int nN, total, W, cw, l0;
    __device__ __forceinline__ bool next(int i, pg8::Unit& u) const {
        const int L = l0 + i * W + cw; if (cw < 0 || L >= total) return false;
        u.pm = L / nN; u.pn = L % nN; u.arow = u.pm * 256; u.brow = u.pn * 256; u.aux = 0; u.nval = 256; return true; }
};
struct SchedS5 {
    int nN, total, G, c, off, ldbrows;
    __device__ __forceinline__ bool next(int i, pg8::Unit& u) const {
        const int L = i * G + ((c + G - off) % G); if (L >= total) return false;
        const int g = L / (3 * nN), r = L % (3 * nN); u.pm = r / nN; u.pn = r % nN; u.aux = g;
        u.arow = g * S5ROWSP + u.pm * 256; u.brow = g * ldbrows + u.pn * 256; u.nval = 256; return true; }
};
constexpr int MT_OFF = LDS_MISC + 256;
struct SchedMoE {
    const LAS int* mt; int G, c; bool gather;
    __device__ __forceinline__ bool next(int i, pg8::Unit& u) const {
        const int L = i * G + c, tile = L >> 2; if (tile >= mt[32 + 32]) return false;
        int ts[NEXP];
#pragma unroll
        for (int k = 0; k < NEXP; ++k) ts[k] = mt[32 + k];
        asm volatile("" ::: "memory");
        int e = 0;
#pragma unroll
        for (int k = 1; k < NEXP; ++k) e = (tile >= ts[k]) ? k : e;
        int te = ts[0];
#pragma unroll
        for (int k = 1; k < NEXP; ++k) te = (e == k) ? ts[k] : te;
        const int t0 = tile - te;
        u.pm = tile; u.pn = L & 3; u.aux = e; u.brow = e * 1024 + u.pn * 256;
        u.nval = mt[e] - t0 * 256; u.arow = gather ? e * MOE_CAP + t0 * 256 : tile * 256; return true; }
};

typedef f32x4 AccT[2][2][4][2];
__device__ __forceinline__ u32x4 pack8(const f32x4 a, const f32x4 b) { u32x4 w; w.x = cvt_pk_bf16(a[0], a[1]); w.y = cvt_pk_bf16(a[2], a[3]); w.z = cvt_pk_bf16(b[0], b[1]); w.w = cvt_pk_bf16(b[2], b[3]); return w; }

struct EpiP {
    static constexpr bool PERM = true;
    bf16_t* P; bf16_t* UA; float* SSQP;
    __device__ __forceinline__ void operator()(const AccT& acc, const pg8::Unit& u, int wr, int wc, int fr, int fq) const {
#pragma unroll
        for (int ai = 0; ai < 2; ++ai)
#pragma unroll
            for (int m = 0; m < 4; ++m) {
                const int row = u.pm * 256 + ai * 128 + wr * 64 + m * 16 + fr;
                if (u.pn == 0) {
                    int R, s;
                    if (row < TL) { const int b = row >> 12, tt = row & 4095; R = b * S5NCH + 4 + (tt >> 6); s = tt & 63; }
                    else { const int rc = row - TL, b = rc >> 8, tt = rc & 255; R = b * S5NCH + (tt >> 6); s = tt & 63; }
#pragma unroll
                    for (int bj = 0; bj < 2; ++bj) { const int col = bj * 128 + wc * 32 + 8 * fq, g = col >> 4, h0 = col & 15;
                        *(u32x4*)(UA + ((size_t)(g * S5ROWSP + R) * S5K + s * 16 + h0)) = pack8(acc[ai][bj][m][0], acc[ai][bj][m][1]); }
                } else {
#pragma unroll
                    for (int bj = 0; bj < 2; ++bj) { const int col = u.pn * 256 + bj * 128 + wc * 32 + 8 * fq;
                        *(u32x4*)(P + (size_t)row * PW + col) = pack8(acc[ai][bj][m][0], acc[ai][bj][m][1]);
                        if (u.pn <= 3) {
                            const f32x4 a = acc[ai][bj][m][0], b = acc[ai][bj][m][1];
                            float s = (a[0] * a[0] + a[1] * a[1]) + (a[2] * a[2] + a[3] * a[3]) + (b[0] * b[0] + b[1] * b[1]) + (b[2] * b[2] + b[3] * b[3]);
                            s += __shfl_xor(s, 16); s += __shfl_xor(s, 32);
                            if (fq == 0) SSQP[(size_t)row * 32 + (u.pn - 1) * 8 + bj * 4 + wc] = s;
                        } }
                }
            }
    }
};
struct EpiS5A {
    static constexpr bool PERM = false;
    float* S;
    __device__ __forceinline__ void operator()(const AccT& acc, const pg8::Unit& u, int wr, int wc, int fr, int fq) const {
#pragma unroll
        for (int ai = 0; ai < 2; ++ai)
#pragma unroll
            for (int m = 0; m < 4; ++m) { const int R = u.pm * 256 + ai * 128 + wr * 64 + m * 16 + fr; float* rp = S + (size_t)(u.aux * S5ROWSP + R) * 256;
#pragma unroll
                for (int bj = 0; bj < 2; ++bj)
#pragma unroll
                    for (int n = 0; n < 2; ++n) *(f32x4*)(rp + bj * 128 + wc * 32 + n * 16 + 4 * fq) = acc[ai][bj][m][n]; }
    }
};
struct EpiQ {
    static constexpr bool PERM = true;
    bf16_t* Q; const float* SSQP; const LAS float* ROPE;
    __device__ __forceinline__ void operator()(const AccT& acc, const pg8::Unit& u, int wr, int wc, int fr, int fq) const {
        const bool latent = (u.pm * 256) < TL;
#pragma unroll
        for (int ai = 0; ai < 2; ++ai) {
            f32x4 sv[4][3];
#pragma unroll
            for (int m = 0; m < 4; ++m) { const f32x4* sp = (const f32x4*)(SSQP + (size_t)(u.pm * 256 + ai * 128 + wr * 64 + m * 16 + fr) * 32); sv[m][0] = sp[0]; sv[m][1] = sp[1]; sv[m][2] = sp[2]; }
            asm volatile("" ::: "memory");
#pragma unroll
            for (int m = 0; m < 4; ++m) {
                const int row = u.pm * 256 + ai * 128 + wr * 64 + m * 16 + fr;
                const f32x4 s0 = sv[m][0], s1 = sv[m][1], s2 = sv[m][2];
                const float ss = ((s0[0] + s0[1]) + (s0[2] + s0[3])) + ((s1[0] + s1[1]) + (s1[2] + s1[3])) + ((s2[0] + s2[1]) + (s2[2] + s2[3]));
                const float rstd = __builtin_amdgcn_rsqf(ss * (1.f / 384.f) + EPS);
                const int tt = row & 4095, pos = (fq < 2) ? (tt >> 6) : (tt & 63);
#pragma unroll
                for (int bj = 0; bj < 2; ++bj) {
                    const int col = u.pn * 256 + bj * 128 + wc * 32 + 8 * fq;
                    f32x4 v0 = acc[ai][bj][m][0] * rstd, v1 = acc[ai][bj][m][1] * rstd;
                    const bool rope = latent && (((col >> 5) % 3) == 2);
                    if (rope) {
                        const LAS f32x4* rp = (const LAS f32x4*)(ROPE + pos * 16);
                        const f32x4 t0 = rp[0], t1 = rp[1], t2 = rp[2], t3 = rp[3];
                        const float cs[8] = {t0[0], t0[2], t1[0], t1[2], t2[0], t2[2], t3[0], t3[2]};
                        const float sn[8] = {t0[1], t0[3], t1[1], t1[3], t2[1], t2[3], t3[1], t3[3]};
                        float v[8] = {v0[0], v0[1], v0[2], v0[3], v1[0], v1[1], v1[2], v1[3]};
#pragma unroll
                        for (int i = 0; i < 8; ++i) { const float pr = __shfl_xor(v[i], 16);
                            v[i] = (fq & 1) ? (pr * sn[i] + v[i] * cs[i]) : (v[i] * cs[i] - pr * sn[i]); }
                        v0 = (f32x4){v[0], v[1], v[2], v[3]}; v1 = (f32x4){v[4], v[5], v[6], v[7]};
                    }
                    *(u32x4*)(Q + (size_t)row * QW + col) = pack8(v0 * 0.14724523f, v1 * 0.14724523f);
                }
            }
            asm volatile("" ::: "memory");
        }
    }
};
struct EpiKV {
    static constexpr bool PERM = true;
    bf16_t* KV; const float* SSQP;
    __device__ __forceinline__ void operator()(const AccT& acc, const pg8::Unit& u, int wr, int wc, int fr, int fq) const {
        f32x4 sv[8][2];
#pragma unroll
        for (int ai = 0; ai < 2; ++ai)
#pragma unroll
            for (int m = 0; m < 4; ++m) { const f32x4* sp = (const f32x4*)(SSQP + (size_t)(u.pm * 256 + ai * 128 + wr * 64 + m * 16 + fr) * 32 + 12); sv[ai * 4 + m][0] = sp[0]; sv[ai * 4 + m][1] = sp[1]; }
        asm volatile("" ::: "memory");
#pragma unroll
        for (int ai = 0; ai < 2; ++ai)
#pragma unroll
            for (int m = 0; m < 4; ++m) {
                const int row = u.pm * 256 + ai * 128 + wr * 64 + m * 16 + fr;
                const f32x4 s0 = sv[ai * 4 + m][0], s1 = sv[ai * 4 + m][1];
                const float ss = ((s0[0] + s0[1]) + (s0[2] + s0[3])) + ((s1[0] + s1[1]) + (s1[2] + s1[3]));
                const float rstd = __builtin_amdgcn_rsqf(ss * (1.f / 256.f) + EPS);
#pragma unroll
                for (int bj = 0; bj < 2; ++bj) { const int col = u.pn * 256 + bj * 128 + wc * 32 + 8 * fq;
                    *(u32x4*)(KV + (size_t)row * KVW + col) = pack8(acc[ai][bj][m][0] * rstd, acc[ai][bj][m][1] * rstd); }
            }
        asm volatile("" ::: "memory");
    }
};
struct EpiS5C {
    static constexpr bool PERM = true;
    bf16_t* Y1;
    __device__ __forceinline__ void operator()(const AccT& acc, const pg8::Unit& u, int wr, int wc, int fr, int fq) const {
#pragma unroll
        for (int ai = 0; ai < 2; ++ai)
#pragma unroll
            for (int m = 0; m < 4; ++m) {
                const int R = u.pm * 256 + ai * 128 + wr * 64 + m * 16 + fr;
                if (R < S5ROWS) {
                    const int b = R / S5NCH, ch = R % S5NCH;
                    const int tok0 = (ch < 4) ? (TL + b * CTXL + ch * 64) : (b * SEQ + (ch - 4) * 64);
#pragma unroll
                    for (int bj = 0; bj < 2; ++bj) { const int col = u.pn * 256 + bj * 128 + wc * 32 + 8 * fq, tp = col >> 4, h0 = col & 15;
                        f32x4 a = acc[ai][bj][m][0], c = acc[ai][bj][m][1];
#pragma unroll
                        for (int i = 0; i < 4; ++i) { a[i] = gelu_tanh(a[i]); c[i] = gelu_tanh(c[i]); }
                        *(u32x4*)(Y1 + (size_t)(tok0 + tp) * 256 + u.aux * 16 + h0) = pack8(a, c); }
                }
            }
    }
};
struct EpiGLU {
    static constexpr bool PERM = true;
    const bf16_t* Y1; bf16_t* O;
    __device__ __forceinline__ void operator()(const AccT& acc, const pg8::Unit& u, int wr, int wc, int fr, int fq) const {
#pragma unroll
        for (int ai = 0; ai < 2; ++ai) {
            u32x4 yv[4][2];
#pragma unroll
            for (int m = 0; m < 4; ++m)
#pragma unroll
                for (int bj = 0; bj < 2; ++bj) yv[m][bj] = *(const u32x4*)(Y1 + (size_t)(u.pm * 256 + ai * 128 + wr * 64 + m * 16 + fr) * 256 + bj * 128 + wc * 32 + 8 * fq);
            asm volatile("" ::: "memory");
#pragma unroll
            for (int m = 0; m < 4; ++m) {
                const int row = u.pm * 256 + ai * 128 + wr * 64 + m * 16 + fr;
#pragma unroll
                for (int bj = 0; bj < 2; ++bj) { const int col = bj * 128 + wc * 32 + 8 * fq;
                    const u32x4 y = yv[m][bj];
                    const f32x4 a = acc[ai][bj][m][0], c = acc[ai][bj][m][1];
                    f32x4 o0, o1;
                    o0[0] = bflo(y.x) * sigmoidf_(a[0]); o0[1] = bfhi(y.x) * sigmoidf_(a[1]); o0[2] = bflo(y.y) * sigmoidf_(a[2]); o0[3] = bfhi(y.y) * sigmoidf_(a[3]);
                    o1[0] = bflo(y.z) * sigmoidf_(c[0]); o1[1] = bfhi(y.z) * sigmoidf_(c[1]); o1[2] = bflo(y.w) * sigmoidf_(c[2]); o1[3] = bfhi(y.w) * sigmoidf_(c[3]);
                    *(u32x4*)(O + (size_t)row * 256 + col) = pack8(o0, o1); }
            }
            asm volatile("" ::: "memory");
        }
    }
};
struct EpiOut {
    static constexpr bool PERM = false;
    float* XL; const float* MODL; float* SSQ;
    const float* RS0; const float* RS1;
    __device__ __forceinline__ void operator()(const AccT& acc, const pg8::Unit& u, int wr, int wc, int fr, int fq) const {
        const int rb = row_b(u.pm * 256);
        const float* mp = MODL + (size_t)rb * 6144 + 2 * DM + u.pn * 256;
        const float* rs = (u.pm * 256 < TL) ? RS0 : RS1;
        float sq[2][4];
#pragma unroll
        for (int ai = 0; ai < 2; ++ai)
#pragma unroll
            for (int m = 0; m < 4; ++m) sq[ai][m] = 0.f;
#pragma unroll
        for (int bj = 0; bj < 2; ++bj)
#pragma unroll
            for (int n = 0; n < 2; ++n) { const int c = bj * 128 + wc * 32 + n * 16 + 4 * fq; const f32x4 g = *(const f32x4*)(mp + c);
                f32x4 t[8];
#pragma unroll
                for (int ai = 0; ai < 2; ++ai)
#pragma unroll
                    for (int m = 0; m < 4; ++m) { const int row = u.pm * 256 + ai * 128 + wr * 64 + m * 16 + fr; t[ai * 4 + m] = *(const f32x4*)(rs + (size_t)row * DM + u.pn * 256 + c); }
                asm volatile("" ::: "memory");
#pragma unroll
                for (int ai = 0; ai < 2; ++ai)
#pragma unroll
                    for (int m = 0; m < 4; ++m) { const int row = u.pm * 256 + ai * 128 + wr * 64 + m * 16 + fr;
                        const f32x4 v = t[ai * 4 + m] + g * acc[ai][bj][m][n]; *(f32x4*)(XL + (size_t)row * DM + u.pn * 256 + c) = v;
                        sq[ai][m] += (v[0] * v[0] + v[1] * v[1]) + (v[2] * v[2] + v[3] * v[3]); } }
#pragma unroll
        for (int ai = 0; ai < 2; ++ai)
#pragma unroll
            for (int m = 0; m < 4; ++m) { float s = sq[ai][m]; s += __shfl_xor(s, 16); s += __shfl_xor(s, 32);
                if (fq == 0) SSQ[(size_t)(u.pm * 256 + ai * 128 + wr * 64 + m * 16 + fr) * 32 + u.pn * 4 + wc] = s; }
    }
};
struct EpiUp {
    static constexpr bool PERM = true;
    bf16_t* HID;
    __device__ __forceinline__ void operator()(const AccT& acc, const pg8::Unit& u, int wr, int wc, int fr, int fq) const {
#pragma unroll
        for (int ai = 0; ai < 2; ++ai)
#pragma unroll
            for (int m = 0; m < 4; ++m) { const int row = u.pm * 256 + ai * 128 + wr * 64 + m * 16 + fr;
                f32x4 h0, h1;
#pragma unroll
                for (int i = 0; i < 4; ++i) { h0[i] = siluf_(acc[ai][0][m][0][i]) * acc[ai][1][m][0][i]; h1[i] = siluf_(acc[ai][0][m][1][i]) * acc[ai][1][m][1][i]; }
                *(u32x4*)(HID + (size_t)row * MOEH + u.pn * 128 + wc * 32 + 8 * fq) = pack8(h0, h1); }
    }
};
struct EpiDown {
    static constexpr bool PERM = true;
    bf16_t* YS;
    __device__ __forceinline__ void operator()(const AccT& acc, const pg8::Unit& u, int wr, int wc, int fr, int fq) const {
#pragma unroll
        for (int ai = 0; ai < 2; ++ai)
#pragma unroll
            for (int m = 0; m < 4; ++m) { const int row = u.pm * 256 + ai * 128 + wr * 64 + m * 16 + fr;
#pragma unroll
                for (int bj = 0; bj < 2; ++bj) *(u32x4*)(YS + (size_t)row * DM + u.pn * 256 + bj * 128 + wc * 32 + 8 * fq) = pack8(acc[ai][bj][m][0], acc[ai][bj][m][1]); }
    }
};

namespace fft {
constexpr int N = 8192;
constexpr int LDS_FFT_BYTES = (N + N / 16 + 16) * 8;
__device__ __forceinline__ int PI(int i) { return i + (i >> 4); }
__device__ constexpr float C32[16] = {1.f, 0.98078528040323043f, 0.92387953251128674f, 0.83146961230254524f, 0.70710678118654752f, 0.55557023301960218f, 0.38268343236508977f, 0.19509032201612825f,
                                      0.f, -0.19509032201612825f, -0.38268343236508977f, -0.55557023301960218f, -0.70710678118654752f, -0.83146961230254524f, -0.92387953251128674f, -0.98078528040323043f};
__device__ constexpr float S32[16] = {0.f, 0.19509032201612825f, 0.38268343236508977f, 0.55557023301960218f, 0.70710678118654752f, 0.83146961230254524f, 0.92387953251128674f, 0.98078528040323043f,
                                      1.f, 0.98078528040323043f, 0.92387953251128674f, 0.83146961230254524f, 0.70710678118654752f, 0.55557023301960218f, 0.38268343236508977f, 0.19509032201612825f};
__host__ __device__ constexpr int bitrev(int i, int bits) { int r = 0; for (int b = 0; b < bits; ++b) r |= ((i >> b) & 1) << (bits - 1 - b); return r; }
__host__ __device__ constexpr int ilog2(int n) { int b = 0; while ((1 << b) < n) ++b; return b; }

template <int R, int START = R> __device__ __forceinline__ void dft_inreg(f32x2 (&v)[R]) {
#pragma unroll
    for (int len = START; len >= 2; len >>= 1) {
        const int half = len / 2;
#pragma unroll
        for (int base = 0; base < R; base += len)
#pragma unroll
            for (int k = 0; k < half; ++k) {
                const f32x2 a = v[base + k], b = v[base + k + half];
                v[base + k] = a + b;
                const f32x2 t = a - b;
                const int ti = k * (32 / len);
                if (ti == 0) v[base + k + half] = t;
                else if (ti == 8) v[base + k + half] = (f32x2){t.y, -t.x};
                else { const float c = C32[ti], s = S32[ti]; v[base + k + half] = (f32x2){t.x * c + t.y * s, t.y * c - t.x * s}; }
            }
    }
}
template <int R> __device__ __forceinline__ void pass(LAS f32x2* buf, int Ns, int tid) {
    constexpr int T = N / R, NBF = (T + NTHR - 1) / NTHR, BITS = ilog2(R);
    static_assert(NBF == 1, "one butterfly per thread at most");
    f32x2 v[R];
    int j_ = tid; asm volatile("" : "+v"(j_));
    const int j = j_; const bool act = j < T;
    const int k = j & (Ns - 1);
    if (act) {
        const LAS f32x2* sp = buf + PI(j);
#pragma unroll
        for (int r = 0; r < R; ++r) v[r] = sp[r * (T + T / 16)];
        if (Ns > 1) {
            const float base = -(float)k / (float)(Ns * R);
#pragma unroll
            for (int r = 1; r < R; ++r) { float s, c; sincos_rev(base * (float)r, s, c); const f32x2 x = v[r]; v[r] = (f32x2){x.x * c - x.y * s, x.x * s + x.y * c}; }
        }
        dft_inreg<R>(v);
    }
    __syncthreads();
    if (act) {
        const int j0 = (j - k) * R + k;
#pragma unroll
        for (int q = 0; q < R; ++q) buf[PI(j0 + q * Ns)] = v[bitrev(q, BITS)];
    }
    __syncthreads();
}
__device__ __forceinline__ void pass2_last(LAS f32x2* buf, int tid) {
    asm volatile("" : "+v"(tid));
#pragma unroll
    for (int i = 0; i < 8; ++i) { const int j = tid + NTHR * i;
        const f32x2 a = buf[PI(j)], b = buf[PI(j + 4096)];
        float s, c; sincos_rev(-(float)j * (1.f / 8192.f), s, c);
        const f32x2 bw = {b.x * c - b.y * s, b.x * s + b.y * c};
        buf[PI(j)] = a + bw; buf[PI(j + 4096)] = a - bw; }
    __syncthreads();
}
constexpr int TW_FLOATS2 = 256 + 4096 + 4096;
__device__ __forceinline__ void build_tables(LAS f32x2* tw, int tid) {
    for (int i = tid; i < TW_FLOATS2; i += NTHR) {
        float rev;
        if (i < 256) { const int r = i >> 4, k = i & 15; rev = -(float)(r * k) * (1.f / 256.f); }
        else if (i < 256 + 4096) { const int q = i - 256, r = q >> 8, k = q & 255; rev = -(float)(r * k) * (1.f / 4096.f); }
        else rev = -(float)(i - 4352) * (1.f / 8192.f);
        float s, c; sincos_rev(rev, s, c); tw[i] = (f32x2){c, s};
    }
}
template <int NS> __device__ __forceinline__ void pass16_tab(LAS f32x2* buf, const LAS f32x2* tw, int tid) {
    constexpr int R = 16, T = N / R;
    f32x2 v[R];
    int j_ = tid; asm volatile("" : "+v"(j_));
    const int j = j_, k = j & (NS - 1);
#pragma unroll
    for (int r = 0; r < R; ++r) v[r] = buf[PI(j + r * T)];
    if (NS > 1) {
        const LAS f32x2* t = (NS == 16) ? (tw + k) : (tw + 256 + k);
#pragma unroll
        for (int r = 1; r < R; ++r) { const f32x2 w = t[r * NS]; const f32x2 x = v[r]; v[r] = (f32x2){x.x * w.x - x.y * w.y, x.x * w.y + x.y * w.x}; }
    }
    dft_inreg<R>(v);
    __syncthreads();
    const int j0 = (j - k) * R + k;
#pragma unroll
    for (int q = 0; q < R; ++q) buf[PI(j0 + q * NS)] = v[bitrev(q, 4)];
    __syncthreads();
}
__device__ __forceinline__ void build_tw2(LAS f32x2* tw, int tid) {
    if (tid < 256) { const int r = tid >> 4, k = tid & 15; float s, c; sincos_rev(-(float)(r * k) * (1.f / 256.f), s, c); tw[tid] = (f32x2){c, s}; }
}
template <int NS, bool ZHI = false> __device__ __forceinline__ void pass16_pp(const LAS f32x2* src, LAS f32x2* dst, const LAS f32x2* tw2, const f32x2 tw31, int tid) {
    static_assert(!ZHI || NS == 1, "ZHI (elements 4096.. are zero and not stored) is the first pass only");
    constexpr int R = 16, T = N / R;
    f32x2 v[R];
    int j_ = tid; asm volatile("" : "+v"(j_));
    const int j = j_, k = j & (NS - 1);
    const LAS f32x2* sp = src + PI(j);
#pragma unroll
    for (int r = 0; r < (ZHI ? R / 2 : R); ++r) v[r] = sp[r * (T + T / 16)];
    if (NS == 16) { const LAS f32x2* t = tw2 + k; f32x2 w[R];
#pragma unroll
        for (int r = 1; r < R; ++r) w[r] = t[r * 16];
        asm volatile("" ::: "memory");
#pragma unroll
        for (int r = 1; r < R; ++r) { const f32x2 x = v[r]; v[r] = (f32x2){x.x * w[r].x - x.y * w[r].y, x.x * w[r].y + x.y * w[r].x}; } }
    if (NS == 256) { f32x2 w = tw31;
#pragma unroll
        for (int r = 1; r < R; ++r) { if (r > 1) w = (f32x2){w.x * tw31.x - w.y * tw31.y, w.x * tw31.y + w.y * tw31.x}; const f32x2 x = v[r]; v[r] = (f32x2){x.x * w.x - x.y * w.y, x.x * w.y + x.y * w.x}; } }
    if (ZHI) {
#pragma unroll
        for (int kk = 0; kk < 8; ++kk) { const f32x2 t = v[kk]; const int ti = 2 * kk;
            if (ti == 0) v[kk + 8] = t; else if (ti == 8) v[kk + 8] = (f32x2){t.y, -t.x};
            else { const float c = C32[ti], s = S32[ti]; v[kk + 8] = (f32x2){t.x * c + t.y * s, t.y * c - t.x * s}; } }
        dft_inreg<R, R / 2>(v);
    } else dft_inreg<R>(v);
    const int j0 = (j - k) * R + k;
    LAS f32x2* dp = dst + PI(j0);
    constexpr int QS = (NS == 1) ? 1 : NS + NS / 16;
#pragma unroll
    for (int q = 0; q < R; ++q) dp[q * QS] = v[bitrev(q, 4)];
    __syncthreads();
}
__device__ __forceinline__ void fft8192(LAS f32x2* buf, int tid) {
    pass<16>(buf, 1, tid);
    pass<16>(buf, 16, tid);
    pass<16>(buf, 256, tid);
    pass2_last(buf, tid);
}
}

__device__ __forceinline__ void build_mod(const Ctx& X) {
    const float* c = X.a->in[X.z + I_C]; const float* cc = X.a->in[X.z + I_CCTX]; const float* aw = X.a->in[X.z + I_ADAW]; const float* ab = X.a->in[X.z + I_ADAB];
    float* MOD = (float*)(X.ws + WS_MOD); LAS f32x4* part = (LAS f32x4*)X.lds;
    LAS float* act = (LAS float*)(X.lds + 73728) + X.wave * 1152;
    for (int task = X.vcu; task < NLAYER * 24; task += X.G) {
        const int l = task / 24, cb = task % 24, col = cb * 256 + X.lane * 4, k0 = X.wave * 128;
        __syncthreads();
#pragma unroll
        for (int j = 0; j < 18; ++j) { const int i = X.lane + 64 * j, q = i >> 7, kk = i & 127; const float x = (q < 8) ? c[q * DM + k0 + kk] : cc[k0 + kk]; act[i] = siluf_(x); }
        LDS_WAIT(); asm volatile("" ::: "memory");
        f32x4 acc[9];
#pragma unroll
        for (int q = 0; q < 9; ++q) acc[q] = (f32x4){0.f, 0.f, 0.f, 0.f};
        for (int kb = 0; kb < 128; kb += 8) {
            f32x4 w[8];
#pragma unroll
            for (int j = 0; j < 8; ++j) w[j] = *(const f32x4*)(aw + ((size_t)l * DM + k0 + kb + j) * 6144 + col);
#pragma unroll
            for (int j = 0; j < 8; ++j)
#pragma unroll
                for (int q = 0; q < 9; ++q) acc[q] += act[q * 128 + kb + j] * w[j];
        }
        __syncthreads();
#pragma unroll
        for (int q = 0; q < 9; ++q) part[(X.wave * 9 + q) * 64 + X.lane] = acc[q];
        __syncthreads();
        for (int i = X.tid; i < 9 * 64; i += NTHR) {
            const int q = i >> 6, ln = i & 63; f32x4 sm = *(const f32x4*)(ab + (size_t)l * 6144 + cb * 256 + ln * 4);
#pragma unroll
            for (int w = 0; w < 8; ++w) sm += part[(w * 9 + q) * 64 + ln];
            *(f32x4*)(MOD + ((size_t)l * 9 + q) * 6144 + cb * 256 + ln * 4) = sm;
        }
    }
    __syncthreads();
}
__device__ __forceinline__ void build_rope(const Ctx& X) {
    if (blockIdx.x == 0) {
        float* R = (float*)(X.ws + WS_ROPE); const int pos = X.tid >> 3, idx = X.tid & 7;
        const float inv = __builtin_amdgcn_exp2f(-(float)(2 * idx) * (1.f / 16.f) * 13.287712379549449f);
        float s, c; sincos_rad((float)pos * inv, s, c);
        R[(pos * 8 + idx) * 2] = c; R[(pos * 8 + idx) * 2 + 1] = s;
    }
}
struct S5Lam { float lre, lim, dt; };
__device__ __forceinline__ S5Lam s5_lam(const Ctx& X, int l, int dir, int g, int p) {
    S5Lam r; const int i = ((l * 2 + dir) * S5G + g) * S5P + p;
    r.lre = X.a->in[X.z + I_LRE][i]; r.lim = X.a->in[X.z + I_LIM][i]; r.dt = fast_exp(X.a->in[X.z + I_LDT][(l * 2 + dir) * S5G + g]); return r;
}
__device__ __forceinline__ f32x2 s5_pow(const S5Lam& L, int e) {
    const float m = fast_exp((float)e * L.lre * L.dt); float s, c; sincos_rad_d((double)e * (double)L.lim * (double)L.dt, s, c); return (f32x2){m * c, m * s};
}
__device__ __forceinline__ f32x2 cmul(f32x2 a, f32x2 b) { return (f32x2){a.x * b.x - a.y * b.y, a.x * b.y + a.y * b.x}; }
__device__ __forceinline__ f32x2 s5_coef(const S5Lam& L) {
    const f32x2 lb = s5_pow(L, 1); const float nx = lb.x - 1.f, ny = lb.y, d = 1.f / (L.lre * L.lre + L.lim * L.lim);
    return (f32x2){(nx * L.lre + ny * L.lim) * d, (ny * L.lre - nx * L.lim) * d};
}
__device__ __forceinline__ void aux1_ktab(const Ctx& X, int l, int t0, int t1, int w0, int w1) {
    float* KT = (float*)(X.ws + WS_KTAB);
    LAS f32x2* bb = (LAS f32x2*)X.lds;
    LAS f32x2* pw = bb + 1024;
    LAS f32x2* cc = pw + 512;
    if (X.vcu >= w0 && X.vcu < w1) for (int task = t0 + (X.vcu - w0); task < t1; task += w1 - w0) {
        const int jb = task & 7, g = (task >> 3) & 15, dir = task >> 7;
        const float* bre = X.a->in[X.z + I_BRE] + (size_t)((l * 2 + dir) * S5G + g) * S5P * S5H; const float* bim = X.a->in[X.z + I_BIM] + (size_t)((l * 2 + dir) * S5G + g) * S5P * S5H;
        const float* cre = X.a->in[X.z + I_CRE] + (size_t)((l * 2 + dir) * S5G + g) * S5H * S5P; const float* cim = X.a->in[X.z + I_CIM] + (size_t)((l * 2 + dir) * S5G + g) * S5H * S5P;
        __syncthreads();
        {   const int p = X.tid & 63, jj = X.tid >> 6; const S5Lam L = s5_lam(X, l, dir, g, p);
            pw[jj * 64 + p] = s5_pow(L, jb * 8 + jj);
            const f32x2 cf = s5_coef(L);
#pragma unroll
            for (int k = 0; k < 2; ++k) { const int h = jj * 2 + k; bb[p * 16 + h] = cmul(cf, (f32x2){bre[p * 16 + h], bim[p * 16 + h]}); }
#pragma unroll
            for (int k = 0; k < 2; ++k) { const int i = X.tid + NTHR * k; cc[i] = (f32x2){cre[i], cim[i]}; }
        }
        __syncthreads();
        {   const int hq = X.tid & 3, hp = (X.tid >> 2) & 15, jj = X.tid >> 6;
            float o0 = 0.f, o1 = 0.f, o2 = 0.f, o3 = 0.f;
#pragma unroll 8
            for (int p = 0; p < S5P; ++p) { const f32x2 q = cmul(cc[hp * 64 + p], pw[jj * 64 + p]);
                const f32x2 b0 = bb[p * 16 + hq * 4], b1 = bb[p * 16 + hq * 4 + 1], b2 = bb[p * 16 + hq * 4 + 2], b3 = bb[p * 16 + hq * 4 + 3];
                o0 += q.x * b0.x - q.y * b0.y; o1 += q.x * b1.x - q.y * b1.y; o2 += q.x * b2.x - q.y * b2.y; o3 += q.x * b3.x - q.y * b3.y; }
            *(f32x4*)(KT + ((size_t)((dir * S5G + g) * S5LC + jb * 8 + jj) * 16 + hp) * 16 + hq * 4) = (f32x4){o0, o1, o2, o3};
        }
    }
    __syncthreads();
}
__device__ __forceinline__ void aux1_filt(const Ctx& X, int l, int t0, int t1, int w0) {
    LAS float* h1s = (LAS float*)(X.lds);
    LAS float* h2s = h1s + 4096;
    LAS float* w1s = h2s + 4096;
    LAS float* w2s = w1s + 2240;
    LAS float* w3s = w2s + 4224;
    const float* w1 = X.a->in[X.z + I_FW1] + (size_t)l * 33 * 64; const float* b1 = X.a->in[X.z + I_FB1] + l * 64;
    const float* w2 = X.a->in[X.z + I_FW2] + (size_t)l * 64 * 64; const float* b2 = X.a->in[X.z + I_FB2] + l * 64;
    const float* w3 = X.a->in[X.z + I_FW3] + (size_t)l * 64 * 1024; const float* b3 = X.a->in[X.z + I_FB3] + l * 1024;
    const float* fq = X.a->in[X.z + I_FFQ] + l * 128;
    float* FILT = (float*)(X.ws + WS_FILT); float* FILTC = (float*)(X.ws + WS_FILTC);
    const int lane = X.lane, wv = X.wave;
    if (X.vcu >= w0) for (int task = t0 + (X.vcu - w0); task < t1; task += X.G - w0) {
        const int pbk = task >> 2, og = task & 3;
        const bool isctx = pbk >= 64; const int n = isctx ? CTXL : SEQ, idx = (isctx ? pbk - 64 : pbk) * 64 + lane;
        __syncthreads();
        {
            float t1[5], ts[4] = {0.f, 0.f, 0.f, 0.f}, tb3 = 0.f; f32x4 t2[2], t3[8];
#pragma unroll
            for (int j = 0; j < 5; ++j) { const int i = X.tid + NTHR * j; t1[j] = (i < 33 * 64) ? w1[i] : 0.f; }
            if (X.tid < 64) { ts[0] = b1[X.tid]; ts[1] = fq[X.tid]; ts[2] = b2[X.tid]; ts[3] = fq[64 + X.tid]; }
#pragma unroll
            for (int j = 0; j < 2; ++j) t2[j] = *(const f32x4*)(w2 + (X.tid + NTHR * j) * 4);
#pragma unroll
            for (int j = 0; j < 8; ++j) { const int q4 = X.tid + NTHR * j, r = q4 >> 6, c4 = (q4 & 63) * 4; t3[j] = *(const f32x4*)(w3 + r * 1024 + og * 256 + c4); }
            if (X.tid < 256) tb3 = b3[og * 256 + X.tid];
            asm volatile("" ::: "memory");
#pragma unroll
            for (int j = 0; j < 5; ++j) { const int i = X.tid + NTHR * j; if (i < 33 * 64) w1s[i] = t1[j]; }
            if (X.tid < 64) { w1s[2112 + X.tid] = ts[0]; w1s[2176 + X.tid] = ts[1]; w2s[4096 + X.tid] = ts[2]; w2s[4160 + X.tid] = ts[3]; }
#pragma unroll
            for (int j = 0; j < 2; ++j) *(LAS f32x4*)(w2s + (X.tid + NTHR * j) * 4) = t2[j];
#pragma unroll
            for (int j = 0; j < 8; ++j) { const int q4 = X.tid + NTHR * j; *(LAS f32x4*)(w3s + q4 * 4) = t3[j]; }
            if (X.tid < 256) w3s[16384 + X.tid] = tb3;
        }
        float z[33];
        z[0] = (float)idx / (float)(n - 1);
#pragma unroll
        for (int b = 0; b < 16; ++b) { const float fb = 1e-4f + (float)b * ((15.f - 1e-4f) / 15.f); float sn, cs; sincos_rev(((float)idx / (float)n) * fb, sn, cs); z[1 + b] = cs; z[17 + b] = -sn; }
        __syncthreads();
        for (int jj = 0; jj < 8; ++jj) { const int j = wv * 8 + jj; float a = w1s[2112 + j]; float wr_[33];
#pragma unroll
            for (int i = 0; i < 33; ++i) wr_[i] = w1s[i * 64 + j];
            asm volatile("" ::: "memory");
#pragma unroll
            for (int i = 0; i < 33; ++i) a += z[i] * wr_[i];
            float sn, cs; sincos_rad(w1s[2176 + j] * a, sn, cs); h1s[j * 64 + lane] = sn; }
        __syncthreads();
        {   float a[8];
#pragma unroll
            for (int jj = 0; jj < 8; ++jj) a[jj] = w2s[4096 + wv * 8 + jj];
            for (int i = 0; i < 64; ++i) { const float hv = h1s[i * 64 + lane]; const f32x4 wa = *(const LAS f32x4*)(w2s + i * 64 + wv * 8), wb = *(const LAS f32x4*)(w2s + i * 64 + wv * 8 + 4);
                a[0] += hv * wa[0]; a[1] += hv * wa[1]; a[2] += hv * wa[2]; a[3] += hv * wa[3]; a[4] += hv * wb[0]; a[5] += hv * wb[1]; a[6] += hv * wb[2]; a[7] += hv * wb[3]; }
#pragma unroll
            for (int jj = 0; jj < 8; ++jj) { float sn, cs; sincos_rad(w2s[4160 + wv * 8 + jj] * a[jj], sn, cs); h2s[(wv * 8 + jj) * 64 + lane] = sn; }
        }
        __syncthreads();
        {   f32x4 acc[8];
#pragma unroll
            for (int q = 0; q < 8; ++q) acc[q] = *(const LAS f32x4*)(w3s + 16384 + wv * 32 + q * 4);
            for (int i = 0; i < 64; ++i) { const float hv = h2s[i * 64 + lane];
#pragma unroll
                for (int q = 0; q < 8; ++q) acc[q] += hv * *(const LAS f32x4*)(w3s + i * 256 + wv * 32 + q * 4); }
            const int dir = og >> 1, o = og & 1; const float tn = z[0];
#pragma unroll
            for (int q = 0; q < 32; ++q) { const int ch = wv * 32 + q;
                const float delta = 3.0701134573253944f + (15.350567286626973f - 3.0701134573253944f) * (float)ch * (1.f / 255.f);
                const float v = acc[q >> 2][q & 3] * fast_exp(-tn * delta);
                if (isctx) FILTC[((size_t)(o * 2 + dir) * HYW + ch) * CTXL + idx] = v;
                else { float* f = FILT + (size_t)(o * HYW + ch) * HYN2;
                    if (dir == 0) f[idx] = v; else if (idx == 0) f[SEQ] = 0.f; else f[HYN2 - idx] = v; } }
        }
    }
    __syncthreads();
}
__device__ __forceinline__ void aux1(const Ctx& X, int l) { aux1_ktab(X, l, 0, 2 * S5G * 8, 0, X.G); aux1_filt(X, l, 0, 68 * 4, 0); }
__device__ __forceinline__ void transpose_item(const float* W, int N, int k0, int n0, bf16_t* dst  , int ldk, const float* gk, LAS float* scr, int lane) {
    f32x4 tv[8]; float tg[8];
#pragma unroll
    for (int i = 0; i < 8; ++i) { const int kk = 8 * i + (lane >> 3), nq = (lane & 7) * 4; tv[i] = *(const f32x4*)(W + (size_t)(k0 + kk) * N + n0 + nq); tg[i] = gk ? gk[k0 + kk] : 1.f; }
    asm volatile("" ::: "memory");
#pragma unroll
    for (int i = 0; i < 8; ++i) { const int kk = 8 * i + (lane >> 3), nq = (lane & 7) * 4; const f32x4 v = tv[i] * tg[i];
        LAS float* d = scr + kk * 33 + nq; d[0] = v[0]; d[1] = v[1]; d[2] = v[2]; d[3] = v[3]; }
    LDS_WAIT(); asm volatile("" ::: "memory");
    const int c = lane & 7;
    float rb[4][8];
#pragma unroll
    for (int j = 0; j < 4; ++j) { const LAS float* s = scr + (8 * c) * 33 + (lane >> 3) + 8 * j;
#pragma unroll
        for (int i = 0; i < 8; ++i) rb[j][i] = s[i * 33]; }
    asm volatile("" ::: "memory");
#pragma unroll
    for (int j = 0; j < 4; ++j) { const int n = (lane >> 3) + 8 * j;
        u32x4 o; o.x = cvt_pk_bf16(rb[j][0], rb[j][1]); o.y = cvt_pk_bf16(rb[j][2], rb[j][3]); o.z = cvt_pk_bf16(rb[j][4], rb[j][5]); o.w = cvt_pk_bf16(rb[j][6], rb[j][7]);
        *(u32x4*)(dst + (size_t)n * ldk + 8 * c) = o; }
    LDS_WAIT(); asm volatile("" ::: "memory");
}
__device__ __forceinline__ void aux2(const Ctx& X, int l) {
    const int lane = X.lane;
    {
        bf16_t* TMV = (bf16_t*)(X.ws + WS_TMV); const float* KT = (const float*)(X.ws + WS_KTAB); const float* dvec = X.a->in[X.z + I_S5D] + l * 256;
        for (int row = X.gw; row < S5G * 1024; row += X.ngw) {
            const int g = row >> 10, tp = (row >> 4) & 63, hp = row & 15;
            for (int ck = lane; ck < 160; ck += 64) {
                float v[8];
                if (ck < 128) {
                    const int s = ck >> 1, h0 = (ck & 1) * 8;
                    const int lag0 = (tp - s) > 0 ? (tp - s) : 0, lag1 = (s - tp) > 0 ? (s - tp) : 0;
                    const f32x4* k0 = (const f32x4*)(KT + ((size_t)((0 * S5G + g) * S5LC + lag0) * 16 + hp) * 16 + h0);
                    const f32x4* k1 = (const f32x4*)(KT + ((size_t)((1 * S5G + g) * S5LC + lag1) * 16 + hp) * 16 + h0);
                    const f32x4 a0 = k0[0], a1 = k0[1], b0 = k1[0], b1 = k1[1];
                    const float m0 = (s <= tp) ? 1.f : 0.f, m1 = (s >= tp) ? 1.f : 0.f;
                    const f32x4 r0 = a0 * m0 + b0 * m1, r1 = a1 * m0 + b1 * m1;
                    v[0] = r0[0]; v[1] = r0[1]; v[2] = r0[2]; v[3] = r0[3]; v[4] = r1[0]; v[5] = r1[1]; v[6] = r1[2]; v[7] = r1[3];
                    if (s == tp && (hp >> 3) == (ck & 1)) { const float dd = dvec[g * 16 + hp];
#pragma unroll
                        for (int i = 0; i < 8; ++i) v[i] += (i == (hp & 7)) ? dd : 0.f; }
                } else {
                    const int kk = (ck - 128) * 8, which = kk >> 6, p0 = kk & 63, dir = which >> 1, e = dir ? (64 - tp) : (tp + 1);
                    const float* cre = X.a->in[X.z + I_CRE] + (size_t)(((l * 2 + dir) * S5G + g) * S5H + hp) * S5P; const float* cim = X.a->in[X.z + I_CIM] + (size_t)(((l * 2 + dir) * S5G + g) * S5H + hp) * S5P;
#pragma unroll
                    for (int i = 0; i < 8; ++i) { const S5Lam L = s5_lam(X, l, dir, g, p0 + i); const f32x2 z = cmul((f32x2){cre[p0 + i], cim[p0 + i]}, s5_pow(L, e)); v[i] = (which & 1) ? -z.y : z.x; }
                }
                u32x4 o; o.x = cvt_pk_bf16(v[0], v[1]); o.y = cvt_pk_bf16(v[2], v[3]); o.z = cvt_pk_bf16(v[4], v[5]); o.w = cvt_pk_bf16(v[6], v[7]);
                *(u32x4*)(TMV + (size_t)row * S5K + ck * 8) = o;
            }
        }
    }
    {
        bf16_t* WMT = (bf16_t*)(X.ws + WS_WMT);
        for (int row = X.gw; row < S5G * 256; row += X.ngw) {
            const int g = row >> 8, n = row & 255, dir = n >> 7, part = (n >> 6) & 1, p = n & 63;
            const S5Lam L = s5_lam(X, l, dir, g, p); const f32x2 cf = s5_coef(L);
            const float* bre = X.a->in[X.z + I_BRE] + ((size_t)((l * 2 + dir) * S5G + g) * S5P + p) * S5H; const float* bim = X.a->in[X.z + I_BIM] + ((size_t)((l * 2 + dir) * S5G + g) * S5P + p) * S5H;
            for (int ck = lane; ck < 128; ck += 64) {
                const int s = ck >> 1, h0 = (ck & 1) * 8, e = dir ? s : (63 - s);
                const f32x2 pw = cmul(s5_pow(L, e), cf); float v[8];
#pragma unroll
                for (int i = 0; i < 8; ++i) { const f32x2 z = cmul(pw, (f32x2){bre[h0 + i], bim[h0 + i]}); v[i] = part ? z.y : z.x; }
                u32x4 o; o.x = cvt_pk_bf16(v[0], v[1]); o.y = cvt_pk_bf16(v[2], v[3]); o.z = cvt_pk_bf16(v[4], v[5]); o.w = cvt_pk_bf16(v[6], v[7]);
                *(u32x4*)(WMT + (size_t)row * 1024 + ck * 8) = o;
            }
        }
    }
    {
        const int gt = X.vcu * NTHR + X.tid;
        if (gt < 2 * S5G * S5P) { const int p = gt & 63, g = (gt >> 6) & 15, dir = gt >> 10; const S5Lam L = s5_lam(X, l, dir, g, p); const f32x2 z = s5_pow(L, S5LC);
            *(f32x2*)((float*)(X.ws + WS_LAML) + (size_t)gt * 2) = z; }
    }
    {
        LAS float* scr = (LAS float*)(X.lds + 73728) + X.wave * 2112;
        constexpr int I_WINI = 16 * 53, I_UQ = 6 * 24, I_UKV = 4 * 32, I_OUT = 16 * 32, I_GL = 4 * 8, NIT = I_WINI + I_UQ + I_UKV + I_OUT + I_GL;
        bf16_t* WIN = (bf16_t*)(X.ws + WS_WIN); bf16_t* WUQ = (bf16_t*)(X.ws + WS_WUQ); bf16_t* WUKV = (bf16_t*)(X.ws + WS_WUKV); bf16_t* WOUT = (bf16_t*)(X.ws + WS_WOUT); bf16_t* GLW = (bf16_t*)(X.ws + WS_GLUW);
        for (int it = X.gw; it < NIT; it += X.ngw) {
            int r = it;
            if (r < I_WINI) { const int kb = r / 53, nb = r % 53; transpose_item(X.a->in[X.z + I_WIN] + (size_t)l * DM * P_IN, P_IN, kb * 64, nb * 32, WIN + (size_t)(nb * 32) * DM + kb * 64, DM, nullptr, scr, lane); continue; } r -= I_WINI;
            if (r < I_UQ) { const int kb = r / 24, nb = r % 24; transpose_item(X.a->in[X.z + I_WUQ] + (size_t)l * 384 * QW, QW, kb * 64, nb * 32, WUQ + (size_t)(nb * 32) * 384 + kb * 64, 384, X.a->in[X.z + I_QNG] + l * 384, scr, lane); continue; } r -= I_UQ;
            if (r < I_UKV) { const int kb = r / 32, nb = r % 32; transpose_item(X.a->in[X.z + I_WUKV] + (size_t)l * 256 * KVW, KVW, kb * 64, nb * 32, WUKV + (size_t)(nb * 32) * 256 + kb * 64, 256, X.a->in[X.z + I_KVNG] + l * 256, scr, lane); continue; } r -= I_UKV;
            if (r < I_OUT) { const int kb = r / 32, nb = r % 32; transpose_item(X.a->in[X.z + I_WOUT] + (size_t)l * DM * DM, DM, kb * 64, nb * 32, WOUT + (size_t)(nb * 32) * DM + kb * 64, DM, nullptr, scr, lane); continue; } r -= I_OUT;
            { const int kb = r / 8, nb = r % 8; transpose_item(X.a->in[X.z + I_GLU] + (size_t)l * 256 * 256, 256, kb * 64, nb * 32, GLW + (size_t)(nb * 32) * 256 + kb * 64, 256, nullptr, scr, lane); }
        }
        unsigned zz = 0u; asm volatile("" : "+v"(zz));
        for (int i = X.vcu * NTHR + X.tid; i < (PW - P_IN) * DM / 8; i += X.G * NTHR) *(u32x4*)(WIN + (size_t)P_IN * DM + (size_t)i * 8) = (u32x4){zz, zz, zz, zz};
    }
}
__device__ __forceinline__ void aux2_spec(const Ctx& X, int l, int t0, int t1, int w0) {
    LAS f32x2* bufA = (LAS f32x2*)X.lds; LAS f32x2* bufB = (LAS f32x2*)(X.lds + 69888); LAS f32x2* tw2 = (LAS f32x2*)(X.lds + 139776);
    const float* FILT = (const float*)(X.ws + WS_FILT); f32x2* SPEC = (f32x2*)(X.ws + WS_SPEC);
    if (X.vcu < w0) return;
    __syncthreads();
    fft::build_tw2(tw2, X.tid);
    f32x2 tw31, tw40;
    { float sn, cs; sincos_rev(-(float)(X.tid & 255) * (1.f / 4096.f), sn, cs); tw31 = (f32x2){cs, sn}; }
    { float sn, cs; sincos_rev(-(float)X.tid * (1.f / 8192.f), sn, cs); tw40 = (f32x2){cs, sn}; }
    const int pt = X.tid + (X.tid >> 4);
    for (int task = t0 + (X.vcu - w0); task < t1; task += X.G - w0) {
        int tid = X.tid; asm volatile("" : "+v"(tid));
        const float* fa = FILT + (size_t)(2 * task) * HYN2; const float* fb = fa + HYN2;
        float ra[16], rb[16];
#pragma unroll
        for (int i = 0; i < 16; ++i) { ra[i] = fa[tid + NTHR * i]; rb[i] = fb[tid + NTHR * i]; }
        __syncthreads();
#pragma unroll
        for (int i = 0; i < 16; ++i) bufA[pt + 544 * i] = (f32x2){ra[i], rb[i]};
        __syncthreads();
        fft::pass16_pp<1>(bufA, bufB, tw2, tw31, tid); fft::pass16_pp<16>(bufB, bufA, tw2, tw31, tid); fft::pass16_pp<256>(bufA, bufB, tw2, tw31, tid);
        {   f32x2 w = tw40;
#pragma unroll
            for (int i = 0; i < 8; ++i) { if (i) w = (f32x2){w.x * 0.92387953251128674f + w.y * 0.38268343236508977f, w.y * 0.92387953251128674f - w.x * 0.38268343236508977f};
                const f32x2 a = bufB[pt + 544 * i], b = bufB[pt + 544 * i + 4352];
                const f32x2 bw = {b.x * w.x - b.y * w.y, b.x * w.y + b.y * w.x};
                bufB[pt + 544 * i] = a + bw; bufB[pt + 544 * i + 4352] = a - bw; } }
        __syncthreads();
        f32x2* oa = SPEC + (size_t)(2 * task) * HYN2; f32x2* ob = oa + HYN2;
#pragma unroll
        for (int i = 0; i < 16; ++i) { const int f = tid + NTHR * i, fn = (HYN2 - f) & (HYN2 - 1);
            const f32x2 zf = bufB[pt + 544 * i], zn = bufB[fft::PI(fn)];
            oa[f] = (f32x2){0.5f * (zf.x + zn.x), 0.5f * (zf.y - zn.y)};
            ob[f] = (f32x2){0.5f * (zf.y + zn.y), -0.5f * (zf.x - zn.x)}; }
    }
    __syncthreads();
}
struct TrItem { const float* src; bf16_t* dst; int N, ldk; };
__device__ __forceinline__ TrItem aux3_item(const Ctx& X, int l, int it, bf16_t* W13, bf16_t* W2T) {
    const bool up = it < NEXP * 512; const int j2 = it - NEXP * 512; const int e = up ? (it >> 9) : (j2 >> 8), which = up ? ((it >> 8) & 1) : 2, q = (up ? it : j2) & 255; TrItem t;
    if (which < 2) { const int kb = q >> 4, n0 = (q & 15) * 32; t.N = MOEH; t.ldk = DM;
        t.src = X.a->in[X.z + (which == 0 ? I_W1 : I_W3)] + ((size_t)l * NEXP + e) * DM * MOEH + (size_t)(kb * 64) * MOEH + n0;
        t.dst = W13 + (size_t)(e * 1024 + (n0 >> 7) * 256 + which * 128 + (n0 & 127)) * DM + kb * 64;
    } else { const int kb = q >> 5, nb = q & 31; t.N = DM; t.ldk = MOEH;
        t.src = X.a->in[X.z + I_W2] + ((size_t)l * NEXP + e) * MOEH * DM + (size_t)(kb * 64) * DM + nb * 32;
        t.dst = W2T + (size_t)(e * 1024 + nb * 32) * MOEH + kb * 64; }
    return t;
}
__device__ __forceinline__ void aux3(const Ctx& X, int l) {
    LAS float* scr = (LAS float*)(X.lds) + X.wave * 2112;
    bf16_t* W13 = (bf16_t*)(X.ws + WS_W13); bf16_t* W2T = (bf16_t*)(X.ws + WS_W2T);
    const int lane = X.lane, kq = lane >> 3, nq = (lane & 7) * 4;
    f32x4 cur[8], nxt[8];
    TrItem tc = aux3_item(X, l, X.gw, W13, W2T);
#pragma unroll
    for (int i = 0; i < 8; ++i) cur[i] = *(const f32x4*)(tc.src + (size_t)(8 * i + kq) * tc.N + nq);
    for (int it = X.gw; it < NEXP * 768; it += X.ngw) {
        const int itn = it + X.ngw; const bool more = itn < NEXP * 768;
        TrItem tn = tc;
        if (more) { tn = aux3_item(X, l, itn, W13, W2T);
#pragma unroll
            for (int i = 0; i < 8; ++i) nxt[i] = *(const f32x4*)(tn.src + (size_t)(8 * i + kq) * tn.N + nq); }
#pragma unroll
        for (int i = 0; i < 8; ++i) { LAS float* d = scr + (8 * i + kq) * 33 + nq; d[0] = cur[i][0]; d[1] = cur[i][1]; d[2] = cur[i][2]; d[3] = cur[i][3]; }
        LDS_WAIT(); asm volatile("" ::: "memory");
        const int c = lane & 7;
        float rb[4][8];
#pragma unroll
        for (int j = 0; j < 4; ++j) { const LAS float* sp = scr + (8 * c) * 33 + (lane >> 3) + 8 * j;
#pragma unroll
            for (int i = 0; i < 8; ++i) rb[j][i] = sp[i * 33]; }
        asm volatile("" ::: "memory");
#pragma unroll
        for (int j = 0; j < 4; ++j) { const int n = (lane >> 3) + 8 * j;
            u32x4 o; o.x = cvt_pk_bf16(rb[j][0], rb[j][1]); o.y = cvt_pk_bf16(rb[j][2], rb[j][3]); o.z = cvt_pk_bf16(rb[j][4], rb[j][5]); o.w = cvt_pk_bf16(rb[j][6], rb[j][7]);
            *(u32x4*)(tc.dst + (size_t)n * tc.ldk + 8 * c) = o; }
        LDS_WAIT(); asm volatile("" ::: "memory");
        tc = tn;
#pragma unroll
        for (int i = 0; i < 8; ++i) cur[i] = nxt[i];
    }
}
__device__ __forceinline__ void aux3_range(const Ctx& X, int l, int k0, int k1) {
    LAS float* scr = (LAS float*)(X.lds) + X.wave * 2112;
    bf16_t* W13 = (bf16_t*)(X.ws + WS_W13); bf16_t* W2T = (bf16_t*)(X.ws + WS_W2T);
    const int lane = X.lane, kq = lane >> 3, nq = (lane & 7) * 4;
    f32x4 cur[8], nxt[8];
    if (X.gw + k0 * X.ngw >= NEXP * 768) return;
    TrItem tc = aux3_item(X, l, X.gw + k0 * X.ngw, W13, W2T);
#pragma unroll
    for (int i = 0; i < 8; ++i) cur[i] = *(const f32x4*)(tc.src + (size_t)(8 * i + kq) * tc.N + nq);
    for (int k = k0; k < k1; ++k) {
        const int itn = X.gw + (k + 1) * X.ngw; const bool more = (k + 1 < k1) && itn < NEXP * 768;
        TrItem tn = tc;
        if (more) { tn = aux3_item(X, l, itn, W13, W2T);
#pragma unroll
            for (int i = 0; i < 8; ++i) nxt[i] = *(const f32x4*)(tn.src + (size_t)(8 * i + kq) * tn.N + nq); }
#pragma unroll
        for (int i = 0; i < 8; ++i) { LAS float* d = scr + (8 * i + kq) * 33 + nq; d[0] = cur[i][0]; d[1] = cur[i][1]; d[2] = cur[i][2]; d[3] = cur[i][3]; }
        LDS_WAIT(); asm volatile("" ::: "memory");
        const int c = lane & 7;
        float rb[4][8];
#pragma unroll
        for (int j = 0; j < 4; ++j) { const LAS float* sp = scr + (8 * c) * 33 + (lane >> 3) + 8 * j;
#pragma unroll
            for (int i = 0; i < 8; ++i) rb[j][i] = sp[i * 33]; }
        asm volatile("" ::: "memory");
#pragma unroll
        for (int j = 0; j < 4; ++j) { const int n = (lane >> 3) + 8 * j;
            u32x4 o; o.x = cvt_pk_bf16(rb[j][0], rb[j][1]); o.y = cvt_pk_bf16(rb[j][2], rb[j][3]); o.z = cvt_pk_bf16(rb[j][4], rb[j][5]); o.w = cvt_pk_bf16(rb[j][6], rb[j][7]);
            *(u32x4*)(tc.dst + (size_t)n * tc.ldk + 8 * c) = o; }
        LDS_WAIT(); asm volatile("" ::: "memory");
        if (!more) break;
        tc = tn;
#pragma unroll
        for (int i = 0; i < 8; ++i) cur[i] = nxt[i];
    }
}
__device__ __forceinline__ int a3k0(int s) { return s == 0 ? 0 : (s == 1 ? 2 : 2 * s - 1); }
__device__ __forceinline__ int a3k1(int s) { return s == 0 ? 2 : (s == 6 ? 12 : 2 * s + 1); }
__device__ __forceinline__ void aux3_left(const Ctx& X, int l, unsigned mask) {
    for (int s = 0; s < 7; ++s) if (!((mask >> s) & 1u)) aux3_range(X, l, a3k0(s), a3k1(s));
    if (X.gw + 12 * X.ngw < NEXP * 768) aux3_range(X, l, 12, (NEXP * 768 - X.gw + X.ngw - 1) / X.ngw);
}

__device__ __forceinline__ void moe_table(const Ctx& X, int l) {
    LAS int* mt = (LAS int*)(X.lds + MT_OFF);
    const int* ecnt = (const int*)(X.ws + WS_CTL) + CW_ECNT + l * NEXP;
    if (X.tid < NEXP) mt[X.tid] = ecnt[X.tid];
    __syncthreads();
    if (X.tid == 0) { int run = 0; for (int e = 0; e < NEXP; ++e) { mt[32 + e] = run; run += (mt[e] + 255) >> 8; } mt[64] = run; }
    __syncthreads();
}
__device__ __forceinline__ void combine_norm(const Ctx& X, int l) {
    float* XL = (float*)(X.ws + WS_XL); bf16_t* ACT = (bf16_t*)(X.ws + WS_ACT); const float* MOD = (const float*)(X.ws + WS_MOD);
    const bf16_t* YS = (const bf16_t*)(X.ws + WS_GX); const int* SLOT = (const int*)(X.ws + WS_SLOT); const float* GATE = (const float*)(X.ws + WS_GATE);
    const int lane = X.lane;
    const int nrows = (l == NLAYER) ? TL : TT;
    const LAS int* mt = (const LAS int*)(X.lds + MT_OFF);
    struct SlotInfo { int q0, q1; float g0, g1; };
    struct RowData { f32x4 x[4]; u32x2 a[4], b[4]; };
#define CN_SLOT(S_, R_) do { if (l > 0 && (R_) < nrows) { (S_).q0 = SLOT[(R_) * 2]; (S_).q1 = SLOT[(R_) * 2 + 1]; (S_).g0 = GATE[(R_) * 2]; (S_).g1 = GATE[(R_) * 2 + 1]; } } while (0)
#define CN_DATA(D_, S_, R_) do { if ((R_) < nrows) { \
        if (l == 0) { const float* src = ((R_) < TL) ? X.a->in[X.z + I_X] + (size_t)(R_) * DM : X.a->in[X.z + I_CTX] + (size_t)((R_) - TL) * DM; \
            _Pragma("unroll") for (int j = 0; j < 4; ++j) (D_).x[j] = *(const f32x4*)(src + 4 * lane + 256 * j); } \
        else { const int s0 = mt[32 + ((S_).q0 >> 20)] * 256 + ((S_).q0 & 0xfffff), s1 = mt[32 + ((S_).q1 >> 20)] * 256 + ((S_).q1 & 0xfffff);     \
            _Pragma("unroll") for (int j = 0; j < 4; ++j) { const int col = 4 * lane + 256 * j; (D_).x[j] = *(const f32x4*)(XL + (size_t)(R_) * DM + col); \
                (D_).a[j] = *(const u32x2*)(YS + (size_t)s0 * DM + col); (D_).b[j] = *(const u32x2*)(YS + (size_t)s1 * DM + col); } } } } while (0)
    SlotInfo sc, sn, sn2; RowData dc, dn;
    const int step = X.ngw; int row = X.gw;
    CN_SLOT(sc, row); CN_SLOT(sn, row + step);
    CN_DATA(dc, sc, row);
    for (; row < nrows; row += step) {
        CN_DATA(dn, sn, row + step);
        CN_SLOT(sn2, row + 2 * step);
        const int rb = row_b(row);
        f32x4 ma[4], mb[4];
        if (l == 0) {
            const float* g1 = X.a->in[X.z + I_N1G]; const float* m = MOD + (size_t)rb * 6144; f32x4 tg[4], ts[4];
#pragma unroll
            for (int j = 0; j < 4; ++j) { const int col = 4 * lane + 256 * j; tg[j] = *(const f32x4*)(g1 + col); ts[j] = *(const f32x4*)(m + DM + col); mb[j] = *(const f32x4*)(m + col); }
            asm volatile("" ::: "memory");
#pragma unroll
            for (int j = 0; j < 4; ++j) ma[j] = tg[j] * (ts[j] + 1.f);
        } else if (l < NLAYER) { const float* ab = (const float*)(X.ws + WS_MODAB) + ((size_t)l * 9 + rb) * 4 * DM + 2 * DM;
#pragma unroll
            for (int j = 0; j < 4; ++j) { ma[j] = *(const f32x4*)(ab + 4 * lane + 256 * j); mb[j] = *(const f32x4*)(ab + DM + 4 * lane + 256 * j); }
            asm volatile("" ::: "memory"); }
        f32x4 m5v[4];
        if (l > 0) { const float* m5 = MOD + ((size_t)(l - 1) * 9 + rb) * 6144 + 5 * DM;
#pragma unroll
            for (int j = 0; j < 4; ++j) m5v[j] = *(const f32x4*)(m5 + 4 * lane + 256 * j);
            asm volatile("" ::: "memory"); }
        f32x4 v[4];
        if (l == 0) {
#pragma unroll
            for (int j = 0; j < 4; ++j) v[j] = dc.x[j];
        } else {
            const float g0 = sc.g0, g1 = sc.g1;
#pragma unroll
            for (int j = 0; j < 4; ++j) { const u32x2 a = dc.a[j], b = dc.b[j];
                const f32x4 y = {g0 * bflo(a.x) + g1 * bflo(b.x), g0 * bfhi(a.x) + g1 * bfhi(b.x), g0 * bflo(a.y) + g1 * bflo(b.y), g0 * bfhi(a.y) + g1 * bfhi(b.y)};
                v[j] = dc.x[j] + m5v[j] * y; }
        }
        if (l > 0 && l < NLAYER) {
#pragma unroll
            for (int j = 0; j < 4; ++j) *(f32x4*)(XL + (size_t)row * DM + 4 * lane + 256 * j) = v[j];
        }
        float ss = 0.f;
#pragma unroll
        for (int j = 0; j < 4; ++j) ss += (v[j][0] * v[j][0] + v[j][1] * v[j][1]) + (v[j][2] * v[j][2] + v[j][3] * v[j][3]);
        const float rstd = __builtin_amdgcn_rsqf(wave_sum(ss) * (1.f / DM) + EPS);
        if (l == NLAYER) {
            const float* fg = X.a->in[X.z + I_FING];
            f32x4 gv[4];
#pragma unroll
            for (int j = 0; j < 4; ++j) gv[j] = *(const f32x4*)(fg + 4 * lane + 256 * j);
            asm volatile("" ::: "memory");
#pragma unroll
            for (int j = 0; j < 4; ++j) { const int col = 4 * lane + 256 * j; *(f32x4*)(X.a->out + (size_t)row * DM + col) = v[j] * rstd * gv[j]; }
        } else {
#pragma unroll
            for (int j = 0; j < 4; ++j) { const int col = 4 * lane + 256 * j;
                const f32x4 h = (v[j] * rstd) * ma[j] + mb[j];
                u32x2 o; o.x = cvt_pk_bf16(h[0], h[1]); o.y = cvt_pk_bf16(h[2], h[3]); *(u32x2*)(ACT + (size_t)row * DM + col) = o; }
        }
        dc = dn; sc = sn; sn = sn2;
    }
#undef CN_SLOT
#undef CN_DATA
}
__device__ __forceinline__ void kr_hyprep(const Ctx& X, int l) {
    const bf16_t* P = (const bf16_t*)(X.ws + WS_P); bf16_t* KR = (bf16_t*)(X.ws + WS_KR); const float* ROPE = (const float*)(X.ws + WS_ROPE);
    for (int it = X.vcu * NTHR + X.tid; it < TT * 4; it += X.G * NTHR) {
        const int row = it >> 2, q = it & 3;
        const u32x4 a = *(const u32x4*)(P + (size_t)row * PW + P_KR + 8 * q), pb = *(const u32x4*)(P + (size_t)row * PW + P_KR + 8 * (q ^ 1));
        u32x4 o = a;
        if (row < TL) {
            const int tt = row & 4095, pos = (q < 2) ? (tt >> 6) : (tt & 63);
            const f32x4* rp = (const f32x4*)(ROPE + pos * 16); const f32x4 t0 = rp[0], t1 = rp[1], t2 = rp[2], t3 = rp[3];
            const float cs[8] = {t0[0], t0[2], t1[0], t1[2], t2[0], t2[2], t3[0], t3[2]}, sn[8] = {t0[1], t0[3], t1[1], t1[3], t2[1], t2[3], t3[1], t3[3]};
            const float v[8] = {bflo(a.x), bfhi(a.x), bflo(a.y), bfhi(a.y), bflo(a.z), bfhi(a.z), bflo(a.w), bfhi(a.w)};
            const float pr[8] = {bflo(pb.x), bfhi(pb.x), bflo(pb.y), bfhi(pb.y), bflo(pb.z), bfhi(pb.z), bflo(pb.w), bfhi(pb.w)};
            float r[8];
#pragma unroll
            for (int i = 0; i < 8; ++i) r[i] = (q & 1) ? (pr[i] * sn[i] + v[i] * cs[i]) : (v[i] * cs[i] - pr[i] * sn[i]);
            o.x = cvt_pk_bf16(r[0], r[1]); o.y = cvt_pk_bf16(r[2], r[3]); o.z = cvt_pk_bf16(r[4], r[5]); o.w = cvt_pk_bf16(r[6], r[7]);
        }
        *(u32x4*)(KR + (size_t)row * 32 + 8 * q) = o;
    }
    const float* sw = X.a->in[X.z + I_HSW] + (size_t)l * 3 * 768; const float* sb = X.a->in[X.z + I_HSB] + (size_t)l * 768;
    bf16_t* HYT = (bf16_t*)(X.ws + WS_HYT); bf16_t* HYTC = (bf16_t*)(X.ws + WS_HYTC);
    constexpr int HPP = 136;
    LAS unsigned short* tl = (LAS unsigned short*)X.lds;
    constexpr int NT_L = NB * (SEQ / 64) * 6, NT_C = NB * (CTXL / 64) * 6;
    struct KHT { u32x4 v[3]; float w0, w1, w2, bb; };
#define KH_DEC(IT) const bool isc = (IT) >= NT_L; const int r = isc ? (IT) - NT_L : (IT); \
        const int cb = r % 6, q = r / 6, n = isc ? CTXL : SEQ, nb64 = n / 64, tb = q % nb64, b = q / nb64, t0 = tb * 64, ch0 = cb * 128
#define KH_LOAD(D, IT) do { if ((IT) < NT_L + NT_C) { KH_DEC(IT); \
        const bf16_t* src = P + (size_t)(isc ? TL + b * CTXL : b * SEQ) * PW + P_HZ + ch0; \
        _Pragma("unroll") for (int j = 0; j < 3; ++j) { const int ck = X.tid + NTHR * j;                         \
            (D).v[j] = (u32x4){0u, 0u, 0u, 0u}; \
            if (ck < 66 * 16) { const int rr = ck >> 4, c8 = (ck & 15) * 8, t = t0 - 1 + rr; if (t >= 0 && t < n) (D).v[j] = *(const u32x4*)(src + (size_t)t * PW + c8); } } \
        const int ch = ch0 + (X.tid & 127); (D).w0 = sw[ch]; (D).w1 = sw[768 + ch]; (D).w2 = sw[1536 + ch]; (D).bb = sb[ch]; } } while (0)
    KHT cur, nxt;
    KH_LOAD(cur, X.vcu);
    __syncthreads();
    for (int it = X.vcu; it < NT_L + NT_C; it += X.G) {
        KH_DEC(it);
        __syncthreads();
#pragma unroll
        for (int j = 0; j < 3; ++j) { const int ck = X.tid + NTHR * j; if (ck < 66 * 16) { const int rr = ck >> 4, c8 = (ck & 15) * 8; *(LAS u32x4*)(tl + rr * HPP + c8) = cur.v[j]; } }
        KH_LOAD(nxt, it + X.G);
        asm volatile("" ::: "memory");
        __syncthreads();
        {   const int c = X.tid & 127, tq = X.tid >> 7, ch = ch0 + c;
            const float w0 = cur.w0, w1 = cur.w1, w2 = cur.w2, bb = cur.bb;
            float x[18];
#pragma unroll
            for (int k = 0; k < 18; ++k) x[k] = bf2f(tl[(tq * 16 + k) * HPP + c]);
            float z[16];
#pragma unroll
            for (int k = 0; k < 16; ++k) z[k] = w0 * x[k] + w1 * x[k + 1] + w2 * x[k + 2] + bb;
            const int part = ch >> 8, cc = ch & 255;
            bf16_t* dst = (isc ? HYTC + ((size_t)(part * NB + b) * HYW + cc) * CTXL : HYT + ((size_t)(part * NB + b) * HYW + cc) * SEQ) + t0 + tq * 16;
            u32x4 o0, o1;
            o0.x = cvt_pk_bf16(z[0], z[1]); o0.y = cvt_pk_bf16(z[2], z[3]); o0.z = cvt_pk_bf16(z[4], z[5]); o0.w = cvt_pk_bf16(z[6], z[7]);
            o1.x = cvt_pk_bf16(z[8], z[9]); o1.y = cvt_pk_bf16(z[10], z[11]); o1.z = cvt_pk_bf16(z[12], z[13]); o1.w = cvt_pk_bf16(z[14], z[15]);
            *(u32x4*)dst = o0; *(u32x4*)(dst + 8) = o1;
        }
        cur = nxt;
    }
#undef KH_DEC
#undef KH_LOAD
    __syncthreads();
}
__device__ __forceinline__ void s5_scan(const Ctx& X) {
    if (X.wave != 0) return;
    const float* S = (const float*)(X.ws + WS_S5S); bf16_t* UA = (bf16_t*)(X.ws + WS_UA); const float* LAML = (const float*)(X.ws + WS_LAML);
    for (int chain = X.vcu; chain < NB * S5G * 2; chain += X.G) {
        const int dir = chain & 1, g = (chain >> 1) & 15, b = chain >> 5, p = X.lane;
        const f32x2 lamL = *(const f32x2*)(LAML + (size_t)((dir * S5G + g) * S5P + p) * 2);
        f32x2 H = {0.f, 0.f};
        f32x2 s[68];
#pragma unroll
        for (int i = 0; i < 68; ++i) { const int step = i; const int ch = dir ? (step < 4 ? 3 - step : 71 - step) : step;
            const float* sp = S + ((size_t)(g * S5ROWSP + b * S5NCH + ch)) * 256 + dir * 128 + p; s[i] = (f32x2){sp[0], sp[64]}; }
#pragma unroll
        for (int i = 0; i < 68; ++i) { const int step = i; const int ch = dir ? (step < 4 ? 3 - step : 71 - step) : step;
            bf16_t* hp = UA + ((size_t)(g * S5ROWSP + b * S5NCH + ch)) * S5K + 1024 + dir * 128 + p;
            hp[0] = f2bf(H.x); hp[64] = f2bf(H.y);
            H = cmul(lamL, H) + s[i]; }
    }
}
__device__ __forceinline__ void merge_groups(const Ctx& X, int l, int nrows) {
    const bf16_t* Y1 = (const bf16_t*)(X.ws + WS_Y1); const bf16_t* GLW = (const bf16_t*)(X.ws + WS_GLUW);
    const bf16_t* MLAO = (const bf16_t*)(X.ws + WS_MLAO); const bf16_t* HYO = (const bf16_t*)(X.ws + WS_HYO); const bf16_t* HYOC = (const bf16_t*)(X.ws + WS_HYOC);
    bf16_t* ACT = (bf16_t*)(X.ws + WS_ACT); const float* mg = X.a->in[X.z + I_MIXG] + l * DM; const int lane = X.lane;
    const f32x4 ga = *(const f32x4*)(mg + 4 * lane), gb0 = *(const f32x4*)(mg + 256 + 8 * lane), gb1 = *(const f32x4*)(mg + 260 + 8 * lane), gc = *(const f32x4*)(mg + 768 + 4 * lane);
    constexpr int HP = 264;
    LAS unsigned short* hyl = (LAS unsigned short*)X.lds;
    LAS unsigned short* y1l = hyl + 64 * HP;
    LAS unsigned short* s5l = y1l + 64 * HP;
    const int r32 = lane & 31, hi = lane >> 5;
    bf16x8 wf[16];
    if (X.vcu < nrows / 64) {
#pragma unroll
        for (int s = 0; s < 16; ++s) wf[s] = *(const bf16x8*)(GLW + (size_t)(32 * X.wave + r32) * 256 + 16 * s + 8 * hi);
    }
    struct MTile { u32x4 mv4[8], yv[4], hv[4]; };
#define MT_LOAD(D, TILE) do { if ((TILE) < nrows / 64) { const int row0_ = (TILE) * 64; \
        _Pragma("unroll") for (int j = 0; j < 8; ++j) { const int row = row0_ + X.wave * 8 + j; (D).mv4[j] = *(const u32x4*)(MLAO + (size_t)row * 512 + 8 * lane); } \
        _Pragma("unroll") for (int j = 0; j < 4; ++j) { const int ck = X.tid + NTHR * j, rr = ck >> 5, c8 = (ck & 31) * 8; (D).yv[j] = *(const u32x4*)(Y1 + (size_t)(row0_ + rr) * 256 + c8); } \
        {   const int c = X.tid >> 1, hf = X.tid & 1; \
            const bf16_t* src = (row0_ < TL) ? HYO + ((size_t)(row0_ >> 12) * HYW + c) * SEQ + (row0_ & 4095) + hf * 32 \
                                             : HYOC + ((size_t)((row0_ - TL) >> 8) * HYW + c) * CTXL + ((row0_ - TL) & 255) + hf * 32; \
            _Pragma("unroll") for (int j = 0; j < 4; ++j) (D).hv[j] = *(const u32x4*)(src + 8 * j); } } } while (0)
    MTile cur, nxt;
    MT_LOAD(cur, X.vcu);
    for (int tile = X.vcu; tile < nrows / 64; tile += X.G) {
        const int row0 = tile * 64;
        __syncthreads();
        {   const int c = X.tid >> 1, hf = X.tid & 1;
#pragma unroll
            for (int j = 0; j < 4; ++j) { const int ck = X.tid + NTHR * j, rr = ck >> 5, c8 = (ck & 31) * 8; *(LAS u32x4*)(y1l + rr * HP + c8) = cur.yv[j]; }
#pragma unroll
            for (int j = 0; j < 4; ++j) { const unsigned w[4] = {cur.hv[j].x, cur.hv[j].y, cur.hv[j].z, cur.hv[j].w};
#pragma unroll
                for (int k = 0; k < 4; ++k) { const int t = hf * 32 + j * 8 + k * 2; hyl[t * HP + c] = (unsigned short)(w[k] & 0xffffu); hyl[(t + 1) * HP + c] = (unsigned short)(w[k] >> 16); } }
        }
        MT_LOAD(nxt, tile + X.G);
        asm volatile("" ::: "memory");
        __syncthreads();
        {   f32x16 acc0 = {}, acc1 = {};
            const LAS unsigned short* yr0 = y1l + r32 * HP; const LAS unsigned short* yr1 = y1l + (32 + r32) * HP;
#pragma unroll
            for (int s = 0; s < 16; ++s) { const bf16x8 b0 = *(const LAS bf16x8*)(yr0 + 16 * s + 8 * hi), b1 = *(const LAS bf16x8*)(yr1 + 16 * s + 8 * hi);
                acc0 = __builtin_amdgcn_mfma_f32_32x32x16_bf16(wf[s], b0, acc0, 0, 0, 0); acc1 = __builtin_amdgcn_mfma_f32_32x32x16_bf16(wf[s], b1, acc1, 0, 0, 0); }
#pragma unroll
            for (int q = 0; q < 4; ++q) { const int n0 = 32 * X.wave + 8 * q + 4 * hi;
                const u32x2 y0 = *(const LAS u32x2*)(yr0 + n0), y1v = *(const LAS u32x2*)(yr1 + n0);
                u32x2 o0, o1;
                o0.x = cvt_pk_bf16(bflo(y0.x) * sigmoidf_(acc0[4 * q]), bfhi(y0.x) * sigmoidf_(acc0[4 * q + 1])); o0.y = cvt_pk_bf16(bflo(y0.y) * sigmoidf_(acc0[4 * q + 2]), bfhi(y0.y) * sigmoidf_(acc0[4 * q + 3]));
                o1.x = cvt_pk_bf16(bflo(y1v.x) * sigmoidf_(acc1[4 * q]), bfhi(y1v.x) * sigmoidf_(acc1[4 * q + 1])); o1.y = cvt_pk_bf16(bflo(y1v.y) * sigmoidf_(acc1[4 * q + 2]), bfhi(y1v.y) * sigmoidf_(acc1[4 * q + 3]));
                *(LAS u32x2*)(s5l + r32 * HP + n0) = o0; *(LAS u32x2*)(s5l + (32 + r32) * HP + n0) = o1; }
        }
        __syncthreads();
#pragma unroll
        for (int j = 0; j < 8; ++j) {
            const int row = row0 + X.wave * 8 + j;
            const u32x4 m = cur.mv4[j];
            const u32x2 a = *(const LAS u32x2*)(s5l + (X.wave * 8 + j) * HP + 4 * lane);
            const u32x2 hw = *(const LAS u32x2*)(hyl + (X.wave * 8 + j) * HP + 4 * lane);
            const float hy[4] = {bflo(hw.x), bfhi(hw.x), bflo(hw.y), bfhi(hw.y)};
            const float s5v[4] = {bflo(a.x), bfhi(a.x), bflo(a.y), bfhi(a.y)};
            const float mv[8] = {bflo(m.x), bfhi(m.x), bflo(m.y), bfhi(m.y), bflo(m.z), bfhi(m.z), bflo(m.w), bfhi(m.w)};
            float q0 = 0.f, q1 = 0.f, q2 = 0.f;
#pragma unroll
            for (int i = 0; i < 4; ++i) { q0 += s5v[i] * s5v[i]; q2 += hy[i] * hy[i]; }
#pragma unroll
            for (int i = 0; i < 8; ++i) q1 += mv[i] * mv[i];
            const float r0 = __builtin_amdgcn_rsqf(wave_sum(q0) * (1.f / 256.f) + EPS), r1 = __builtin_amdgcn_rsqf(wave_sum(q1) * (1.f / 512.f) + EPS), r2 = __builtin_amdgcn_rsqf(wave_sum(q2) * (1.f / 256.f) + EPS);
            u32x2 o0; o0.x = cvt_pk_bf16(s5v[0] * r0 * ga[0], s5v[1] * r0 * ga[1]); o0.y = cvt_pk_bf16(s5v[2] * r0 * ga[2], s5v[3] * r0 * ga[3]);
            u32x4 o1; o1.x = cvt_pk_bf16(mv[0] * r1 * gb0[0], mv[1] * r1 * gb0[1]); o1.y = cvt_pk_bf16(mv[2] * r1 * gb0[2], mv[3] * r1 * gb0[3]);
            o1.z = cvt_pk_bf16(mv[4] * r1 * gb1[0], mv[5] * r1 * gb1[1]); o1.w = cvt_pk_bf16(mv[6] * r1 * gb1[2], mv[7] * r1 * gb1[3]);
            u32x2 o2; o2.x = cvt_pk_bf16(hy[0] * r2 * gc[0], hy[1] * r2 * gc[1]); o2.y = cvt_pk_bf16(hy[2] * r2 * gc[2], hy[3] * r2 * gc[3]);
            bf16_t* d = ACT + (size_t)row * DM;
            *(u32x2*)(d + 4 * lane) = o0; *(u32x4*)(d + 256 + 8 * lane) = o1; *(u32x2*)(d + 768 + 4 * lane) = o2;
        }
        cur = nxt;
    }
#undef MT_LOAD
    __syncthreads();
}
__device__ __forceinline__ void build_modab(const Ctx& X) {
    const float* MOD = (const float*)(X.ws + WS_MOD); float* AB = (float*)(X.ws + WS_MODAB);
    for (int i = X.vcu * NTHR + X.tid; i < NLAYER * 9 * DM; i += X.G * NTHR) { const int c = i & (DM - 1), lr = i >> 10, l = lr / 9;
        const float* m = MOD + (size_t)lr * 6144; const float g2 = X.a->in[X.z + I_N2G][l * DM + c], g1 = X.a->in[X.z + I_N1G][l * DM + c];
        float* o = AB + (size_t)lr * 4 * DM + c;
        o[0] = g2 * (m[4 * DM + c] + 1.f); o[DM] = m[3 * DM + c]; o[2 * DM] = g1 * (m[DM + c] + 1.f); o[3 * DM] = m[c]; }
}
constexpr int RT_PITCH = 2064;
constexpr int RT_WBYTES = 2 * 36 * RT_PITCH;
constexpr int RT_HIST = RT_WBYTES;
__device__ __forceinline__ void norm2_router(const Ctx& X, int l, int RPW) {
    const float* XL = (const float*)(X.ws + WS_XL); bf16_t* ACT = (bf16_t*)(X.ws + WS_ACT); const float* MODAB = (const float*)(X.ws + WS_MODAB);
    float* GATE = (float*)(X.ws + WS_GATE); int* SLOT = (int*)(X.ws + WS_SLOT); int* RTOK = (int*)(X.ws + WS_RTOK);
    LAS unsigned char* W = X.lds; LAS int* hist = (LAS int*)(X.lds + RT_HIST); LAS int* gbase = hist + 32; LAS int* lcnt = hist + 64; LAS int* eidl = hist + 96;
    const int lane = X.lane;
    {   const float* wg = X.a->in[X.z + I_WGRP] + (size_t)l * DM * 4; const float* we = X.a->in[X.z + I_WEXP] + (size_t)l * DM * 32;
        { float t[8];
#pragma unroll
          for (int j = 0; j < 8; ++j) t[j] = wg[X.tid + NTHR * j];
#pragma unroll
          for (int j = 0; j < 8; ++j) { const int i = X.tid + NTHR * j; const float w = t[j]; const unsigned short hi = f2bf(w), lo = f2bf(w - bf2f(hi)); const int o = i & 3, k = i >> 2;
            *(LAS unsigned short*)(W + o * RT_PITCH + k * 2) = hi; *(LAS unsigned short*)(W + (36 + o) * RT_PITCH + k * 2) = lo; } }
        for (int b = 0; b < 4; ++b) { float t[16];
#pragma unroll
          for (int j = 0; j < 16; ++j) t[j] = we[X.tid + NTHR * (b * 16 + j)];
#pragma unroll
          for (int j = 0; j < 16; ++j) { const int i = X.tid + NTHR * (b * 16 + j); const float w = t[j]; const unsigned short hi = f2bf(w), lo = f2bf(w - bf2f(hi)); const int o = 4 + (i & 31), k = i >> 5;
            *(LAS unsigned short*)(W + o * RT_PITCH + k * 2) = hi; *(LAS unsigned short*)(W + (36 + o) * RT_PITCH + k * 2) = lo; } }
        if (X.tid < 32) hist[X.tid] = 0;
    }
    __syncthreads();
    const float* g2 = X.a->in[X.z + I_N2G] + l * DM;
    const int row0 = blockIdx.x * RPW, tok = lane & 15, kg = lane >> 4;
    const int orow[3] = {tok, 16 + tok, (32 + tok) < 36 ? 32 + tok : 35};
    struct RLd { f32x4 x[2], a[2], b[2]; };
#define RT_LOAD(D, S_) do { const int s_ = ((S_) < se) ? (S_) : se - 1;        \
        _Pragma("unroll") for (int q = 0; q < 2; ++q) { (D).x[q] = *(const f32x4*)(xr + 32 * s_ + 4 * q); (D).a[q] = *(const f32x4*)(ab + 32 * s_ + 4 * q); (D).b[q] = *(const f32x4*)(ab + DM + 32 * s_ + 4 * q); } } while (0)
#define RT_STEP(C, S_, ACC) do { const int s = (S_); \
            float h[8]; \
            _Pragma("unroll") for (int q = 0; q < 2; ++q) { const f32x4 v = ((C).x[q] * rstd) * (C).a[q] + (C).b[q]; h[4 * q] = v[0]; h[4 * q + 1] = v[1]; h[4 * q + 2] = v[2]; h[4 * q + 3] = v[3]; } \
            u32x4 hi, lo; \
            hi.x = cvt_pk_bf16(h[0], h[1]); hi.y = cvt_pk_bf16(h[2], h[3]); hi.z = cvt_pk_bf16(h[4], h[5]); hi.w = cvt_pk_bf16(h[6], h[7]); \
            lo.x = cvt_pk_bf16(h[0] - bflo(hi.x), h[1] - bfhi(hi.x)); lo.y = cvt_pk_bf16(h[2] - bflo(hi.y), h[3] - bfhi(hi.y)); \
            lo.z = cvt_pk_bf16(h[4] - bflo(hi.z), h[5] - bfhi(hi.z)); lo.w = cvt_pk_bf16(h[6] - bflo(hi.w), h[7] - bfhi(hi.w)); \
            if (valid) *(u32x4*)(ACT + (size_t)row * DM + 32 * s + 8 * kg) = hi; \
            const bf16x8 bh = *reinterpret_cast<const bf16x8*>(&hi), bl = *reinterpret_cast<const bf16x8*>(&lo); \
            _Pragma("unroll") for (int ot = 0; ot < 3; ++ot) { \
                const bf16x8 ah = *(const LAS bf16x8*)(W + orow[ot] * RT_PITCH + (32 * s + 8 * kg) * 2), al = *(const LAS bf16x8*)(W + (36 + orow[ot]) * RT_PITCH + (32 * s + 8 * kg) * 2); \
                (ACC)[ot] = __builtin_amdgcn_mfma_f32_16x16x32_bf16(ah, bh, (ACC)[ot], 0, 0, 0); \
                (ACC)[ot] = __builtin_amdgcn_mfma_f32_16x16x32_bf16(al, bh, (ACC)[ot], 0, 0, 0); \
                (ACC)[ot] = __builtin_amdgcn_mfma_f32_16x16x32_bf16(ah, bl, (ACC)[ot], 0, 0, 0); } } while (0)
#define RT_KLOOP(TILE, S0, NS, ACC) do { \
        const int ti = (TILE) * 16 + tok; const bool valid = ti < RPW; const int row = row0 + (valid ? ti : RPW - 1); \
        const float* xr = XL + (size_t)row * DM + 8 * kg; const float* ab = MODAB + ((size_t)l * 9 + row_b(row)) * 4 * DM + 8 * kg; \
        float ss; \
        {   const f32x4* sp = (const f32x4*)((const float*)(X.ws + WS_SSQP) + (size_t)row * 32); const f32x4 s0 = sp[0], s1 = sp[1], s2 = sp[2], s3 = sp[3]; \
            ss = (((s0[0] + s0[1]) + (s0[2] + s0[3])) + ((s1[0] + s1[1]) + (s1[2] + s1[3]))) + (((s2[0] + s2[1]) + (s2[2] + s2[3])) + ((s3[0] + s3[1]) + (s3[2] + s3[3]))); } \
        const float rstd = __builtin_amdgcn_rsqf(ss * (1.f / DM) + EPS); \
        _Pragma("unroll") for (int ot = 0; ot < 3; ++ot) (ACC)[ot] = (f32x4){0.f, 0.f, 0.f, 0.f}; \
        const int se = (S0) + (NS); \
        RLd c0, c1, c2, c3; RT_LOAD(c0, (S0)); RT_LOAD(c1, (S0) + 1); RT_LOAD(c2, (S0) + 2); \
        _Pragma("unroll 1") for (int sb = (S0); sb < se; sb += 4) { \
            RT_LOAD(c3, sb + 3); RT_STEP(c0, sb, ACC); \
            RT_LOAD(c0, sb + 4); RT_STEP(c1, sb + 1, ACC); \
            RT_LOAD(c1, sb + 5); RT_STEP(c2, sb + 2, ACC); \
            RT_LOAD(c2, sb + 6); RT_STEP(c3, sb + 3, ACC); } } while (0)
#define RT_FINISH(TILE, ACC) do { \
        const int ti = (TILE) * 16 + tok; const bool valid = ti < RPW; const int row = row0 + (valid ? ti : RPW - 1); \
        float lg[48]; \
        _Pragma("unroll") for (int ot = 0; ot < 3; ++ot) _Pragma("unroll") for (int i = 0; i < 4; ++i) { \
                lg[16 * ot + i] = (ACC)[ot][i]; \
                _Pragma("unroll") for (int k2 = 1; k2 < 4; ++k2) lg[16 * ot + 4 * k2 + i] = __shfl((ACC)[ot][i], tok + 16 * k2); } \
        if (kg == 0 && valid) { \
            float gm = lg[0]; int gi = 0; \
            _Pragma("unroll") for (int i = 1; i < 4; ++i) { if (lg[i] > gm) { gm = lg[i]; gi = i; } } \
            float den = 0.f; \
            _Pragma("unroll") for (int i = 0; i < 4; ++i) den += fast_exp(lg[i] - gm); \
            const float gw = 1.f / den; \
            float cand[8]; \
            _Pragma("unroll") for (int j = 0; j < 8; ++j) { cand[j] = lg[4 + j]; \
                _Pragma("unroll") for (int g = 1; g < 4; ++g) cand[j] = (gi == g) ? lg[4 + 8 * g + j] : cand[j]; } \
            float v0 = -3.0e38f, v1 = -3.0e38f; int i0 = 0, i1 = 0; \
            _Pragma("unroll") for (int i = 0; i < 8; ++i) { const float v = cand[i]; \
                if (v > v0) { v1 = v0; i1 = i0; v0 = v; i0 = i; } else if (v > v1) { v1 = v; i1 = i; } } \
            const float e1 = fast_exp(v1 - v0), inv = 1.f / (1.f + e1); \
            const int e0i = gi * 8 + i0, e1i = gi * 8 + i1; \
            eidl[ti * 2] = e0i; eidl[ti * 2 + 1] = e1i; GATE[row * 2] = gw * inv; GATE[row * 2 + 1] = gw * e1 * inv; \
            atomicAdd((int*)&hist[e0i], 1); atomicAdd((int*)&hist[e1i], 1); } } while (0)
    f32x4 pacc[3];
    {   f32x4 acc[3]; RT_KLOOP(X.wave, 0, 32, acc); RT_FINISH(X.wave, acc); }
    if (RPW > 128) {
    RT_KLOOP(8, 4 * X.wave, 4, pacc);
    __syncthreads();
    {   LAS f32x4* P = (LAS f32x4*)W;
#pragma unroll
        for (int ot = 0; ot < 3; ++ot) P[(X.wave * 3 + ot) * 64 + lane] = pacc[ot]; }
    __syncthreads();
    if (X.wave == 0) {   const LAS f32x4* P = (const LAS f32x4*)W; f32x4 acc[3];
#pragma unroll
        for (int ot = 0; ot < 3; ++ot) { acc[ot] = P[ot * 64 + lane];
#pragma unroll
            for (int w = 1; w < NWAVES; ++w) acc[ot] += P[(w * 3 + ot) * 64 + lane]; }
        RT_FINISH(8, acc); }
    }
#undef RT_LOAD
#undef RT_STEP
#undef RT_KLOOP
#undef RT_FINISH
    __syncthreads();
    if (X.tid < 32) { gbase[X.tid] = (int)atomicAdd((unsigned*)(X.ws + WS_CTL) + CW_ECNT + l * NEXP + X.tid, (unsigned)hist[X.tid]); lcnt[X.tid] = 0; }
    __syncthreads();
    if (X.tid < 2 * RPW) { const int e = eidl[X.tid], pos = gbase[e] + atomicAdd((int*)&lcnt[e], 1), tokr = row0 + (X.tid >> 1);
        RTOK[(size_t)e * MOE_CAP + pos] = tokr; SLOT[tokr * 2 + (X.tid & 1)] = (e << 20) | pos; }
}

namespace attn {
constexpr int NW = 8, QBLK = 32, KVBLK = 64;
constexpr float SCALE = 0.10206207261596575f;
constexpr float THR = 8.f;
constexpr int NSLOT = 3, SHM_V = KVBLK * DV * 2  , SHM_K = KVBLK * 256  , SHM_ATTN = NSLOT * (SHM_V + SHM_K) + NW * 64 * 4;
#define KSWZ(row, colB) ((row) * 256 + ((colB) ^ (((row) & 7) << 4)))
#define SBAR() __builtin_amdgcn_sched_barrier(0)
#define QK_PIPE() do { __builtin_amdgcn_sched_group_barrier(0x002, 8, 0); __builtin_amdgcn_sched_group_barrier(0x100, 12, 0); \
    _Pragma("unroll") for (int g_ = 0; g_ < 14; ++g_) { __builtin_amdgcn_sched_group_barrier(0x008, 1, 0); __builtin_amdgcn_sched_group_barrier(0x002, 4, 0); } } while (0)
__device__ __forceinline__ int crow(int r, int hi) { return (r & 3) + 8 * (r >> 2) + 4 * hi; }
constexpr float C_ATT = SCALE * 1.4426950408889634f;
constexpr float THRL = THR * 1.4426950408889634f;
__device__ __forceinline__ void partialSM(f32x16& p0, f32x16& p1, float& m_reg, float& alpha, bf16x8& qm, bool first, int hi) {
  float pmax = p0[0];
#pragma unroll
  for (int r = 1; r < 16; ++r) pmax = fmaxf(pmax, p0[r]);
#pragma unroll
  for (int r = 0; r < 16; ++r) pmax = fmaxf(pmax, p1[r]);
  { auto rr = __builtin_amdgcn_permlane32_swap(__float_as_uint(pmax), __float_as_uint(pmax), false, false);
    pmax = fmaxf(__uint_as_float(rr[0]), __uint_as_float(rr[1])); }
  if (__builtin_expect(!first && __all(pmax <= THRL), 1)) { alpha = 1.f; }
  else {
    const float dlt = first ? pmax : fmaxf(pmax, 0.f);
    m_reg += dlt; alpha = first ? 1.f : __builtin_amdgcn_exp2f(-dlt);
#pragma unroll
    for (int r = 0; r < 16; ++r) { p0[r] -= dlt; p1[r] -= dlt; }
    const float nm = -m_reg; const unsigned w = cvt_pk_bf16(nm, 0.f) & 0xffffu; const float rem = nm - __uint_as_float(w << 16);
    const unsigned w2 = (hi == 0) ? (w | (cvt_pk_bf16(rem, 0.f) << 16)) : 0u;
    const u32x4 q4 = {w2, 0u, 0u, 0u}; qm = *reinterpret_cast<const bf16x8*>(&q4);
  }
#pragma unroll
  for (int r = 0; r < 16; ++r) p0[r] = __builtin_amdgcn_exp2f(p0[r]);
}
__device__ __forceinline__ void finishSM(f32x16& p0, f32x16& p1, bf16x8& pa0, bf16x8& pa1, bf16x8& pa2, bf16x8& pa3) {
#pragma unroll
  for (int r = 0; r < 16; ++r) p1[r] = __builtin_amdgcn_exp2f(p1[r]);
#define PK4(P, BASE, OUT) do { unsigned a0 = cvt_pk_bf16(P[BASE + 0], P[BASE + 1]), a1 = cvt_pk_bf16(P[BASE + 2], P[BASE + 3]);   \
    unsigned b0 = cvt_pk_bf16(P[BASE + 4], P[BASE + 5]), b1 = cvt_pk_bf16(P[BASE + 6], P[BASE + 7]);                              \
    auto r0 = __builtin_amdgcn_permlane32_swap(a0, b0, false, false); auto r1 = __builtin_amdgcn_permlane32_swap(a1, b1, false, false); \
    u32x4 w = {r0[0], r1[0], r0[1], r1[1]}; OUT = *reinterpret_cast<bf16x8*>(&w); } while (0)
  PK4(p0, 0, pa0); PK4(p0, 8, pa1); PK4(p1, 0, pa2); PK4(p1, 8, pa3);
#undef PK4
}
__device__ __forceinline__ void qkt(f32x16& p0, f32x16& p1, const LAS char* Ks, const bf16x8* qr, bf16x8 qm, int r32, int hi) {
  const u32x4 k1 = {hi == 0 ? 0x3f803f80u : 0u, 0u, 0u, 0u}; const bf16x8 kone = *reinterpret_cast<const bf16x8*>(&k1);
  p0 = __builtin_amdgcn_mfma_f32_32x32x16_bf16(kone, qm, f32x16{}, 0, 0, 0);
  p1 = __builtin_amdgcn_mfma_f32_32x32x16_bf16(kone, qm, f32x16{}, 0, 0, 0);
#pragma unroll
  for (int d0 = 0; d0 < 6; ++d0) { const int cb = (d0 * 16 + hi * 8) * 2;
    const bf16x8 b0 = *(const LAS bf16x8*)(Ks + KSWZ(r32, cb));
    const bf16x8 b1 = *(const LAS bf16x8*)(Ks + KSWZ(32 + r32, cb));
    p0 = __builtin_amdgcn_mfma_f32_32x32x16_bf16(b0, qr[d0], p0, 0, 0, 0);
    p1 = __builtin_amdgcn_mfma_f32_32x32x16_bf16(b1, qr[d0], p1, 0, 0, 0); }
}
__device__ __forceinline__ int v_st(int k, int c) { const int kk = (k & ~0xC) | ((k & 4) << 1) | ((k & 8) >> 1); return ((kk >> 3) * 2 + (c >> 5)) * 512 + ((kk & 7) * 32 + (c & 31)) * 2; }
__device__ __forceinline__ int v_rd_base(int lane) { return ((lane & 3) << 3) | (((lane >> 2) & 3) << 6) | (((lane >> 4) & 1) << 5) | (((lane >> 5) & 1) << 8); }
constexpr int v_rd_off(int d0, int ks, int half) { return d0 * 512 + ks * 2048 + half * 1024; }
template <int OFF> __device__ __forceinline__ s16x4 tr_read(int vb) {
  s16x4 r; asm volatile("ds_read_b64_tr_b16 %0, %1 offset:%2" : "=&v"(r) : "v"(vb), "i"(OFF) : "memory"); return r;
}
template <int D0> __device__ __forceinline__ void pv_one(f32x16& od, int vb, bf16x8 pa0, bf16x8 pa1, bf16x8 pa2, bf16x8 pa3) {
  const s16x4 l0 = tr_read<v_rd_off(D0, 0, 0)>(vb), h0 = tr_read<v_rd_off(D0, 0, 1)>(vb), l1 = tr_read<v_rd_off(D0, 1, 0)>(vb), h1 = tr_read<v_rd_off(D0, 1, 1)>(vb);
  const s16x4 l2 = tr_read<v_rd_off(D0, 2, 0)>(vb), h2 = tr_read<v_rd_off(D0, 2, 1)>(vb), l3 = tr_read<v_rd_off(D0, 3, 0)>(vb), h3 = tr_read<v_rd_off(D0, 3, 1)>(vb);
  asm volatile("s_waitcnt lgkmcnt(0)" ::: "memory"); SBAR();
#define PK(L, H) (bf16x8){L[0], L[1], L[2], L[3], H[0], H[1], H[2], H[3]}
  od = __builtin_amdgcn_mfma_f32_32x32x16_bf16(pa0, PK(l0, h0), od, 0, 0, 0);
  od = __builtin_amdgcn_mfma_f32_32x32x16_bf16(pa1, PK(l1, h1), od, 0, 0, 0);
  od = __builtin_amdgcn_mfma_f32_32x32x16_bf16(pa2, PK(l2, h2), od, 0, 0, 0);
  od = __builtin_amdgcn_mfma_f32_32x32x16_bf16(pa3, PK(l3, h3), od, 0, 0, 0);
#undef PK
}
__device__ __forceinline__ void pv_d0(f32x16* o, int vb, bf16x8 pa0, bf16x8 pa1, bf16x8 pa2, bf16x8 pa3) {
  const s16x4 a0 = tr_read<v_rd_off(0, 0, 0)>(vb), b0 = tr_read<v_rd_off(0, 0, 1)>(vb), c0 = tr_read<v_rd_off(1, 0, 0)>(vb), d0 = tr_read<v_rd_off(1, 0, 1)>(vb);
  const s16x4 a1 = tr_read<v_rd_off(0, 1, 0)>(vb), b1 = tr_read<v_rd_off(0, 1, 1)>(vb), c1 = tr_read<v_rd_off(1, 1, 0)>(vb), d1 = tr_read<v_rd_off(1, 1, 1)>(vb);
  const s16x4 a2 = tr_read<v_rd_off(0, 2, 0)>(vb), b2 = tr_read<v_rd_off(0, 2, 1)>(vb), c2 = tr_read<v_rd_off(1, 2, 0)>(vb), d2 = tr_read<v_rd_off(1, 2, 1)>(vb);
  const s16x4 a3 = tr_read<v_rd_off(0, 3, 0)>(vb), b3 = tr_read<v_rd_off(0, 3, 1)>(vb), c3 = tr_read<v_rd_off(1, 3, 0)>(vb), d3 = tr_read<v_rd_off(1, 3, 1)>(vb);
  asm volatile("s_waitcnt lgkmcnt(0)" ::: "memory"); SBAR();
#define PK(L, H) (bf16x8){L[0], L[1], L[2], L[3], H[0], H[1], H[2], H[3]}
  o[0] = __builtin_amdgcn_mfma_f32_32x32x16_bf16(pa0, PK(a0, b0), o[0], 0, 0, 0);
  o[1] = __builtin_amdgcn_mfma_f32_32x32x16_bf16(pa0, PK(c0, d0), o[1], 0, 0, 0);
  o[0] = __builtin_amdgcn_mfma_f32_32x32x16_bf16(pa1, PK(a1, b1), o[0], 0, 0, 0);
  o[1] = __builtin_amdgcn_mfma_f32_32x32x16_bf16(pa1, PK(c1, d1), o[1], 0, 0, 0);
  o[0] = __builtin_amdgcn_mfma_f32_32x32x16_bf16(pa2, PK(a2, b2), o[0], 0, 0, 0);
  o[1] = __builtin_amdgcn_mfma_f32_32x32x16_bf16(pa2, PK(c2, d2), o[1], 0, 0, 0);
  o[0] = __builtin_amdgcn_mfma_f32_32x32x16_bf16(pa3, PK(a3, b3), o[0], 0, 0, 0);
  o[1] = __builtin_amdgcn_mfma_f32_32x32x16_bf16(pa3, PK(c3, d3), o[1], 0, 0, 0);
  { const u32x4 o1 = {0x3f803f80u, 0x3f803f80u, 0x3f803f80u, 0x3f803f80u}; const bf16x8 ones = *reinterpret_cast<const bf16x8*>(&o1);
    o[2] = __builtin_amdgcn_mfma_f32_32x32x16_bf16(pa0, ones, o[2], 0, 0, 0); o[2] = __builtin_amdgcn_mfma_f32_32x32x16_bf16(pa1, ones, o[2], 0, 0, 0);
    o[2] = __builtin_amdgcn_mfma_f32_32x32x16_bf16(pa2, ones, o[2], 0, 0, 0); o[2] = __builtin_amdgcn_mfma_f32_32x32x16_bf16(pa3, ones, o[2], 0, 0, 0); }
#undef PK
}
#define PK4(P, BASE, OUT) do { unsigned a0 = cvt_pk_bf16(P[BASE + 0], P[BASE + 1]), a1 = cvt_pk_bf16(P[BASE + 2], P[BASE + 3]);   \
    unsigned b0 = cvt_pk_bf16(P[BASE + 4], P[BASE + 5]), b1 = cvt_pk_bf16(P[BASE + 6], P[BASE + 7]);                              \
    auto r0 = __builtin_amdgcn_permlane32_swap(a0, b0, false, false); auto r1 = __builtin_amdgcn_permlane32_swap(a1, b1, false, false); \
    u32x4 w = {r0[0], r1[0], r0[1], r1[1]}; OUT = *reinterpret_cast<bf16x8*>(&w); } while (0)
__device__ __forceinline__ void finishSM_a(f32x16& p0, f32x16& p1, bf16x8& pa0, bf16x8& pa1) {
#pragma unroll
  for (int r = 0; r < 16; ++r) p1[r] = __builtin_amdgcn_exp2f(p1[r]);
  PK4(p0, 0, pa0); PK4(p0, 8, pa1);
  asm volatile("" : "+v"(p1));
}
__device__ __forceinline__ void finishSM_b(f32x16& p1, bf16x8& pa2, bf16x8& pa3) { PK4(p1, 0, pa2); PK4(p1, 8, pa3); }
#undef PK4
struct VFrag { s16x4 f[16]; };
__device__ __forceinline__ void pv_readA(f32x16* o, VFrag& v, int vb, bf16x8 pa0, bf16x8 pa1) {
  v.f[0] = tr_read<v_rd_off(0, 0, 0)>(vb); v.f[1] = tr_read<v_rd_off(0, 0, 1)>(vb); v.f[2] = tr_read<v_rd_off(1, 0, 0)>(vb); v.f[3] = tr_read<v_rd_off(1, 0, 1)>(vb);
  v.f[4] = tr_read<v_rd_off(0, 1, 0)>(vb); v.f[5] = tr_read<v_rd_off(0, 1, 1)>(vb); v.f[6] = tr_read<v_rd_off(1, 1, 0)>(vb); v.f[7] = tr_read<v_rd_off(1, 1, 1)>(vb);
  v.f[8] = tr_read<v_rd_off(0, 2, 0)>(vb); v.f[9] = tr_read<v_rd_off(0, 2, 1)>(vb); v.f[10] = tr_read<v_rd_off(1, 2, 0)>(vb); v.f[11] = tr_read<v_rd_off(1, 2, 1)>(vb);
  v.f[12] = tr_read<v_rd_off(0, 3, 0)>(vb); v.f[13] = tr_read<v_rd_off(0, 3, 1)>(vb); v.f[14] = tr_read<v_rd_off(1, 3, 0)>(vb); v.f[15] = tr_read<v_rd_off(1, 3, 1)>(vb);
  asm volatile("s_waitcnt lgkmcnt(0)" ::: "memory"); SBAR();
#define PK(L, H) (bf16x8){L[0], L[1], L[2], L[3], H[0], H[1], H[2], H[3]}
  const u32x4 o1 = {0x3f803f80u, 0x3f803f80u, 0x3f803f80u, 0x3f803f80u}; const bf16x8 ones = *reinterpret_cast<const bf16x8*>(&o1);
  o[0] = __builtin_amdgcn_mfma_f32_32x32x16_bf16(pa0, PK(v.f[0], v.f[1]), o[0], 0, 0, 0);
  o[1] = __builtin_amdgcn_mfma_f32_32x32x16_bf16(pa0, PK(v.f[2], v.f[3]), o[1], 0, 0, 0);
  o[2] = __builtin_amdgcn_mfma_f32_32x32x16_bf16(pa0, ones, o[2], 0, 0, 0);
  o[0] = __builtin_amdgcn_mfma_f32_32x32x16_bf16(pa1, PK(v.f[4], v.f[5]), o[0], 0, 0, 0);
  o[1] = __builtin_amdgcn_mfma_f32_32x32x16_bf16(pa1, PK(v.f[6], v.f[7]), o[1], 0, 0, 0);
  o[2] = __builtin_amdgcn_mfma_f32_32x32x16_bf16(pa1, ones, o[2], 0, 0, 0);
}
__device__ __forceinline__ void pv_B(f32x16* o, const VFrag& v, bf16x8 pa2, bf16x8 pa3) {
  const u32x4 o1 = {0x3f803f80u, 0x3f803f80u, 0x3f803f80u, 0x3f803f80u}; const bf16x8 ones = *reinterpret_cast<const bf16x8*>(&o1);
  o[0] = __builtin_amdgcn_mfma_f32_32x32x16_bf16(pa2, PK(v.f[8], v.f[9]), o[0], 0, 0, 0);
  o[1] = __builtin_amdgcn_mfma_f32_32x32x16_bf16(pa2, PK(v.f[10], v.f[11]), o[1], 0, 0, 0);
  o[2] = __builtin_amdgcn_mfma_f32_32x32x16_bf16(pa2, ones, o[2], 0, 0, 0);
  o[0] = __builtin_amdgcn_mfma_f32_32x32x16_bf16(pa3, PK(v.f[12], v.f[13]), o[0], 0, 0, 0);
  o[1] = __builtin_amdgcn_mfma_f32_32x32x16_bf16(pa3, PK(v.f[14], v.f[15]), o[1], 0, 0, 0);
  o[2] = __builtin_amdgcn_mfma_f32_32x32x16_bf16(pa3, ones, o[2], 0, 0, 0);
#undef PK
}
__device__ __forceinline__ void partialSM_max(f32x16& p0, f32x16& p1, float& m_reg, float& alpha, bf16x8& qm, int hi) {
  float pmax = p0[0];
#pragma unroll
  for (int r = 1; r < 16; ++r) pmax = fmaxf(pmax, p0[r]);
#pragma unroll
  for (int r = 0; r < 16; ++r) pmax = fmaxf(pmax, p1[r]);
  { auto rr = __builtin_amdgcn_permlane32_swap(__float_as_uint(pmax), __float_as_uint(pmax), false, false);
    pmax = fmaxf(__uint_as_float(rr[0]), __uint_as_float(rr[1])); }
  if (__builtin_expect(__all(pmax <= THRL), 1)) { alpha = 1.f; }
  else {
    const float dlt = fmaxf(pmax, 0.f);
    m_reg += dlt; alpha = __builtin_amdgcn_exp2f(-dlt);
#pragma unroll
    for (int r = 0; r < 16; ++r) { p0[r] -= dlt; p1[r] -= dlt; }
    const float nm = -m_reg; const unsigned w = cvt_pk_bf16(nm, 0.f) & 0xffffu; const float rem = nm - __uint_as_float(w << 16);
    const unsigned w2 = (hi == 0) ? (w | (cvt_pk_bf16(rem, 0.f) << 16)) : 0u;
    const u32x4 q4 = {w2, 0u, 0u, 0u}; qm = *reinterpret_cast<const bf16x8*>(&q4);
  }
}
__device__ __forceinline__ void partialSM_exp(f32x16& p0) {
#pragma unroll
  for (int r = 0; r < 16; ++r) p0[r] = __builtin_amdgcn_exp2f(p0[r]);
  asm volatile("" : "+v"(p0));
}
__device__ __forceinline__ int key_row(int b, int kk) { return kk < CTXL ? TL + b * CTXL + kk : b * SEQ + (kk - CTXL); }

__device__ __forceinline__ void attn_phase(const bf16_t* __restrict__ Q, const bf16_t* __restrict__ KV, const bf16_t* __restrict__ KR, bf16_t* __restrict__ O,
                                           int vcu, int G, LAS char* lds, int wave_, bool with_ctx) {
  constexpr int NLU = NB * NHEAD * 16; const int NCU = with_ctx ? NB * NHEAD : 0;
  const int nl = (vcu < NLU) ? (NLU - vcu + G - 1) / G : 0, nc = (vcu < NCU) ? (NCU - vcu + G - 1) / G : 0, nu = nl + nc;
  if (nu == 0) return;
  int tid_ = wave_ * 64 + lane_id(); asm volatile("" : "+v"(tid_));
  const int tid = tid_, wid = tid >> 6, lane = tid & 63, r32 = lane & 31, hi = lane >> 5;
  LAS char* V_lds = lds; LAS char* K_lds = lds + NSLOT * SHM_V;
  LAS float* ws = (LAS float*)(lds + NSLOT * (SHM_V + SHM_K)) + wid * 64; LAS float* al_l = ws + 32;
  const int sr = tid >> 4, c16 = tid & 15, vr = tid >> 3, c8 = tid & 7;
  const bool kact = c16 < 12;
  const int kst0 = KSWZ(sr, c16 * 16), kst1 = KSWZ(32 + sr, c16 * 16), vst = v_st(vr, c8 * 8);
  const int vb0 = (int)(uintptr_t)V_lds + v_rd_base(lane);
  struct { bf16x8 ks0, ks1, vs; } sr_[2];
  bf16x8 qr[6];
  const unsigned kstr = (c16 < 8) ? (unsigned)(KVW * 2) : 64u;
  const char* P0; const char* P1; const char* PV0;
#define UPTR(hh) do { P0 = (c16 < 8) ? (const char*)(KV + (size_t)sr * KVW + (hh) * 128 + c16 * 8) : (const char*)(KR + (size_t)sr * 32 + (c16 - 8) * 8); \
    P1 = P0 + 32 * kstr; PV0 = (const char*)(KV + (size_t)vr * KVW + (hh) * 128 + 64 + c8 * 8); } while (0)
#define UDEC(v, b_, h_, q0_, nt_) do { if ((v) < nl) { const int u_ = vcu + (v) * G, bh_ = u_ >> 4; b_ = bh_ >> 3; h_ = bh_ & 7; q0_ = b_ * SEQ + (u_ & 15) * 256; nt_ = NKEY / 64; } \
    else { const int u_ = vcu + ((v) - nl) * G; b_ = u_ >> 3; h_ = u_ & 7; q0_ = TL + b_ * CTXL; nt_ = CTXL / 64; } } while (0)
#define QLOAD(q0_, hh) do { const bf16_t* Qw_ = Q + (size_t)((q0_) + wid * QBLK + r32) * QW + (hh) * DQK + hi * 8; \
    _Pragma("unroll") for (int d0 = 0; d0 < 6; ++d0) qr[d0] = *(const bf16x8*)(Qw_ + d0 * 16); } while (0)
#define SLOADB(i, k0, bb) do { const unsigned _rb = (unsigned)key_row((bb), (k0)); \
    if (kact) { sr_[i].ks0 = *(const bf16x8*)(P0 + (size_t)_rb * kstr); sr_[i].ks1 = *(const bf16x8*)(P1 + (size_t)_rb * kstr); } \
    sr_[i].vs = *(const bf16x8*)(PV0 + (size_t)_rb * (KVW * 2)); } while (0)
#define SLOAD(i, k0) SLOADB(i, k0, b)
#define SWRITE(slot, i) do { *(LAS bf16x8*)(V_lds + (slot) * SHM_V + vst) = sr_[i].vs; \
    if (kact) { *(LAS bf16x8*)(K_lds + (slot) * SHM_K + kst0) = sr_[i].ks0; *(LAS bf16x8*)(K_lds + (slot) * SHM_K + kst1) = sr_[i].ks1; } } while (0)
#define SWAIT() asm volatile("s_waitcnt vmcnt(3)" ::: "memory")
#define RESC(a) do { if (__any((a) < 1.f)) { if (hi == 0) al_l[r32] = (a); asm volatile("s_waitcnt lgkmcnt(0)" ::: "memory"); \
    _Pragma("unroll") for (int d = 0; d < 3; ++d) _Pragma("unroll") for (int r = 0; r < 16; ++r) o[d][r] *= al_l[crow(r, hi)]; } } while (0)
  int b, h, qrow0, NT; UDEC(0, b, h, qrow0, NT);
  UPTR(h); QLOAD(qrow0, h); SLOAD(0, 0);
  for (int v = 0; v < nu; ++v) {
  float m_reg = 0.f; f32x16 o[3] = {};
  f32x16 pA0, pA1, pB0, pB1; float alA, alB; bf16x8 pa0, pa1, pa2, pa3; bf16x8 qm = {0, 0, 0, 0, 0, 0, 0, 0};
  SWRITE(0, 0); __syncthreads();
  qkt(pA0, pA1, K_lds, qr, qm, r32, hi); partialSM(pA0, pA1, m_reg, alA, qm, true, hi);
  SLOAD(1, KVBLK); if (2 < NT) SLOAD(0, 2 * KVBLK);
  SWAIT(); SWRITE(1, 1); __syncthreads();
  int sj = 1;
  for (int j = 1; j + 1 < NT; j += 2) {
    const int s1 = (sj == 2) ? 0 : sj + 1, s2 = (s1 == 2) ? 0 : s1 + 1, sp = (sj == 0) ? 2 : sj - 1;
    SBAR(); qkt(pB0, pB1, K_lds + sj * SHM_K, qr, qm, r32, hi);
    finishSM_a(pA0, pA1, pa0, pa1); QK_PIPE(); SBAR();
    SLOAD(1, (j + 2) * KVBLK); SBAR();
    { VFrag vf; pv_readA(o, vf, vb0 + sp * SHM_V, pa0, pa1); finishSM_b(pA1, pa2, pa3); partialSM_max(pB0, pB1, m_reg, alB, qm, hi); pv_B(o, vf, pa2, pa3); partialSM_exp(pB0); }
    SWAIT(); SWRITE(s1, 0);
    RESC(alB); __syncthreads();
    SBAR(); qkt(pA0, pA1, K_lds + s1 * SHM_K, qr, qm, r32, hi);
    finishSM_a(pB0, pB1, pa0, pa1); QK_PIPE(); SBAR();
    if (j + 3 < NT) SLOAD(0, (j + 3) * KVBLK); SBAR();
    { VFrag vf; pv_readA(o, vf, vb0 + sj * SHM_V, pa0, pa1); finishSM_b(pB1, pa2, pa3); partialSM_max(pA0, pA1, m_reg, alA, qm, hi); pv_B(o, vf, pa2, pa3); partialSM_exp(pA0); }
    SWAIT(); SWRITE(s2, 1);
    RESC(alA); __syncthreads();
    sj = s2;
  }
  const int oq0 = qrow0, oh = h;
  { const int sp = (sj == 0) ? 2 : sj - 1;
    SBAR(); qkt(pB0, pB1, K_lds + sj * SHM_K, qr, qm, r32, hi);
    finishSM(pA0, pA1, pa0, pa1, pa2, pa3); SBAR();
    if (v + 1 < nu) { UDEC(v + 1, b, h, qrow0, NT); UPTR(h); QLOAD(qrow0, h); SLOAD(0, 0); }
    SBAR();
    pv_d0(o, vb0 + sp * SHM_V, pa0, pa1, pa2, pa3); partialSM(pB0, pB1, m_reg, alB, qm, false, hi);
    RESC(alB);
    finishSM(pB0, pB1, pa0, pa1, pa2, pa3); SBAR();
    pv_d0(o, vb0 + sj * SHM_V, pa0, pa1, pa2, pa3); }
  float rli[16];
#pragma unroll
  for (int r = 0; r < 16; ++r) rli[r] = __builtin_amdgcn_rcpf(o[2][r]);
  bf16_t* Ow = O + (size_t)(oq0 + wid * QBLK) * 512 + oh * DV;
#pragma unroll
  for (int r = 0; r < 16; ++r) { const int orow = crow(r, hi);
#pragma unroll
    for (int d0 = 0; d0 < 2; ++d0) Ow[(size_t)orow * 512 + d0 * 32 + r32] = f2bf(o[d0][r] * rli[r]); }
  __syncthreads();
  }
#undef UPTR
#undef UDEC
#undef QLOAD
#undef SLOADB
#undef SLOAD
#undef SWRITE
#undef SWAIT
#undef RESC
}
#undef KSWZ
}

__device__ __forceinline__ void hyena_conv(const Ctx& X, int l) {
    LAS f32x2* bufA = (LAS f32x2*)X.lds; LAS f32x2* bufB = (LAS f32x2*)(X.lds + 69888); LAS f32x2* tw2 = (LAS f32x2*)(X.lds + 139776);
    const f32x2* SPEC = (const f32x2*)(X.ws + WS_SPEC); const bf16_t* HYT = (const bf16_t*)(X.ws + WS_HYT); bf16_t* HYO = (bf16_t*)(X.ws + WS_HYO);
    const float* hb = X.a->in[X.z + I_HBIAS] + l * 2 * HYW;
    __syncthreads();
    fft::build_tw2(tw2, X.tid);
    f32x2 tw31, tw40;
    { float sn, cs; sincos_rev(-(float)(X.tid & 255) * (1.f / 4096.f), sn, cs); tw31 = (f32x2){cs, sn}; }
    { float sn, cs; sincos_rev(-(float)X.tid * (1.f / 8192.f), sn, cs); tw40 = (f32x2){cs, sn}; }
    unsigned short nv0[8], nv1[8];
#define HY_LOADV(U) do { int tid_ = X.tid; asm volatile("" : "+v"(tid_)); const int c_ = (U) >> 2, bb_ = ((U) & 3) * 2; \
        const unsigned short* p0_ = (const unsigned short*)(HYT + ((size_t)(0 * NB + bb_) * HYW + c_) * SEQ); const unsigned short* p1_ = (const unsigned short*)(HYT + ((size_t)(0 * NB + bb_ + 1) * HYW + c_) * SEQ); \
        _Pragma("unroll") for (int i = 0; i < 8; ++i) { nv0[i] = p0_[tid_ + NTHR * i]; nv1[i] = p1_[tid_ + NTHR * i]; } } while (0)
#define HY_ORDER(o, S, O) do { \
        const f32x2* K = SPEC + (size_t)((o) * HYW + c) * HYN2; \
        f32x2 kr[16]; \
        _Pragma("unroll") for (int i = 0; i < 8; ++i) { kr[2 * i] = K[tid + NTHR * i]; kr[2 * i + 1] = K[tid + NTHR * i + 4096]; } \
        const bf16_t* g0 = HYT + ((size_t)((1 + (o)) * NB + b0) * HYW + c) * SEQ; const bf16_t* g1 = HYT + ((size_t)((1 + (o)) * NB + b1) * HYW + c) * SEQ; \
        fft::pass16_pp<1, true>(S, O, tw2, tw31, tid); fft::pass16_pp<16>(O, S, tw2, tw31, tid); fft::pass16_pp<256>(S, O, tw2, tw31, tid); \
        f32x2 w = tw40; \
        _Pragma("unroll") for (int i = 0; i < 8; ++i) { const int j = tid + NTHR * i; if (i) w = (f32x2){w.x * 0.92387953251128674f + w.y * 0.38268343236508977f, w.y * 0.92387953251128674f - w.x * 0.38268343236508977f}; \
            const f32x2 a = O[pt + 544 * i], b = O[pt + 544 * i + 4352]; \
            const f32x2 bw = {b.x * w.x - b.y * w.y, b.x * w.y + b.y * w.x}; \
            const f32x2 z0 = a + bw, z1 = a - bw, k0 = kr[2 * i], k1 = kr[2 * i + 1]; \
            O[pt + 544 * i] = (f32x2){z0.x * k0.x - z0.y * k0.y, -(z0.x * k0.y + z0.y * k0.x)};             \
            O[pt + 544 * i + 4352] = (f32x2){z1.x * k1.x - z1.y * k1.y, -(z1.x * k1.y + z1.y * k1.x)}; } \
        __syncthreads(); \
        f32x2 gt[8]; \
        _Pragma("unroll") for (int i = 0; i < 8; ++i) { const int t = tid + NTHR * i; gt[i] = (f32x2){bf2f(g0[t]), bf2f(g1[t])}; } \
        if ((o) == 1 && unit + X.G < 4 * HYW) HY_LOADV(unit + X.G); \
        fft::pass16_pp<1>(O, S, tw2, tw31, tid); fft::pass16_pp<16>(S, O, tw2, tw31, tid); fft::pass16_pp<256>(O, S, tw2, tw31, tid); \
        const float bias = hb[(o) * HYW + c]; \
        w = tw40; \
        _Pragma("unroll") for (int i = 0; i < 8; ++i) { const int j = tid + NTHR * i; if (i) w = (f32x2){w.x * 0.92387953251128674f + w.y * 0.38268343236508977f, w.y * 0.92387953251128674f - w.x * 0.38268343236508977f}; \
            const f32x2 a = S[pt + 544 * i], b = S[pt + 544 * i + 4352]; \
            const f32x2 z = {a.x + (b.x * w.x - b.y * w.y), a.y + (b.x * w.y + b.y * w.x)}; \
            const float c0 = z.x * (1.f / HYN2), c1 = -z.y * (1.f / HYN2); \
            yc[i] = (f32x2){gt[i].x * (c0 + yc[i].x * bias), gt[i].y * (c1 + yc[i].y * bias)}; } } while (0)
    if (X.vcu < 4 * HYW) HY_LOADV(X.vcu);
    for (int unit = X.vcu; unit < 4 * HYW; unit += X.G) {
        int tid = X.tid; asm volatile("" : "+v"(tid));
        const int c = unit >> 2, b0 = (unit & 3) * 2, b1 = b0 + 1;
        const int pt = tid + (tid >> 4);
        f32x2 yc[8];
#pragma unroll
        for (int i = 0; i < 8; ++i) yc[i] = (f32x2){__uint_as_float((unsigned)nv0[i] << 16), __uint_as_float((unsigned)nv1[i] << 16)};
#pragma unroll
        for (int i = 0; i < 8; ++i) bufA[pt + 544 * i] = yc[i];
        __syncthreads();
        HY_ORDER(0, bufA, bufB);
#pragma unroll
        for (int i = 0; i < 8; ++i) bufB[pt + 544 * i] = yc[i];
        __syncthreads();
        HY_ORDER(1, bufB, bufA);
        {   bf16_t* o0 = HYO + ((size_t)b0 * HYW + c) * SEQ; bf16_t* o1 = HYO + ((size_t)b1 * HYW + c) * SEQ;
#pragma unroll
            for (int i = 0; i < 8; ++i) { const int t = tid + NTHR * i; o0[t] = f2bf(yc[i].x); o1[t] = f2bf(yc[i].y); } }
    }
#undef HY_ORDER
#undef HY_LOADV
    __syncthreads();
}
__device__ __forceinline__ void hyena_conv_ctx(const Ctx& X, int l) {
    const float* FILTC = (const float*)(X.ws + WS_FILTC); const bf16_t* HYTC = (const bf16_t*)(X.ws + WS_HYTC); bf16_t* HYOC = (bf16_t*)(X.ws + WS_HYOC);
    const float* hb = X.a->in[X.z + I_HBIAS] + l * 2 * HYW;
    const int half = X.tid >> 8, t = X.tid & 255;
    LAS f32x4* yv = (LAS f32x4*)X.lds;
    LAS float* kf = (LAS float*)(X.lds + 8192); LAS float* kb = kf + 256;
    for (int c = X.vcu; c < HYW; c += X.G) {
        f32x4 y;
#pragma unroll
        for (int q = 0; q < 4; ++q) y[q] = bf2f(HYTC[((size_t)(0 * NB + half * 4 + q) * HYW + c) * CTXL + t]);
#pragma unroll
        for (int o = 0; o < 2; ++o) {
            const float fv = FILTC[((size_t)(o * 2 + half) * HYW + c) * CTXL + t];
            unsigned short gr[4];
#pragma unroll
            for (int q = 0; q < 4; ++q) gr[q] = ((const unsigned short*)HYTC)[((size_t)((1 + o) * NB + half * 4 + q) * HYW + c) * CTXL + t];
            const float hbv = hb[o * HYW + c];
            asm volatile("" ::: "memory");
            __syncthreads();
            yv[half * 256 + t] = y;
            if (half == 0) kf[t] = fv; else kb[t] = fv;
            __syncthreads();
            f32x4 acc = {0.f, 0.f, 0.f, 0.f};
#pragma unroll 4
            for (int s = 0; s < CTXL; ++s) { const int lag = t - s; const float k = (lag >= 0) ? kf[lag] : kb[-lag]; acc += k * yv[half * 256 + s]; }
            f32x4 g;
#pragma unroll
            for (int q = 0; q < 4; ++q) g[q] = __uint_as_float((unsigned)gr[q] << 16);
            y = g * (acc + y * hbv);
        }
#pragma unroll
        for (int q = 0; q < 4; ++q) HYOC[((size_t)(half * 4 + q) * HYW + c) * CTXL + t] = f2bf(y[q]);
    }
    __syncthreads();
}

constexpr int NPH = 2 + 10 * NLAYER;
#ifndef PROBE_MASK
#define PROBE_MASK 0
#endif
#define NREP(k) (1 + ((PROBE_MASK >> (k)) & 1))
__global__ void __launch_bounds__(NTHR, 2) fwd(Args args) {
    extern __shared__ __attribute__((aligned(16))) unsigned char lds_raw[];
    Ctx X;
    X.a = &args; X.ws = args.ws; X.lds = (LAS unsigned char*)lds_raw;
    X.wave = __builtin_amdgcn_readfirstlane((int)threadIdx.x >> 6); X.tid = 0; X.lane = 0;
    X.G = gridDim.x; { const int bx = blockIdx.x; X.vcu = (X.G % 8 == 0) ? (bx % 8) * (X.G / 8) + bx / 8 : bx; }
    X.gw = X.vcu * NWAVES + X.wave; X.ngw = X.G * NWAVES; X.z = 0;
    volatile LAS unsigned* MISC = (volatile LAS unsigned*)(X.lds + LDS_MISC);
    if (threadIdx.x < 16) MISC[threadIdx.x] = 0u;
    __syncthreads();
    const int lo = args.ph_lo, hi = args.ph_hi;
    XcdBarrier bar; bar.bar = (unsigned*)(args.ws + WS_CTL) + CW_BAR + args.li * XCD_BAR_WORDS; bar.x = 0; bar.st = nullptr;
    if (hi - lo > 1) bar = xcd_barrier_post((unsigned*)(args.ws + WS_CTL) + CW_BAR + args.li * XCD_BAR_WORDS, MISC + 8);
#define IN(k) (lo <= (k) && (k) < hi)
#define SEAM(k) do { if (IN(k) && IN((k) + 1)) { for (int rb_ = 0; rb_ < NREP(22); ++rb_) xcd_barrier(bar, X.wave * 64 + lane_id(), (unsigned)X.G); } } while (0)
#define SEAM_BG(k, TL_, S_) SEAM_BG2(k, TL_, S_, S_)
#define SEAM_BG2(k, TL_, S_, S2_) do { if (IN(k) && IN((k) + 1)) { \
        xcd_arrive_f(bar.bar, bar.x, bar.st, X.wave * 64 + lane_id(), (unsigned)X.G); \
        if ((TL_) < NLAYER && MISC[11] == 0u) { const Ctx Yb_ = fresh(X); aux3_range(Yb_, (TL_), a3k0(S_), a3k1(S2_)); if (Yb_.tid == 0) MISC[12] = MISC[12] | (1u << (S_)) | (1u << (S2_)); } \
        xcd_wait_f(bar.bar, bar.x, bar.st, X.wave * 64 + lane_id()); } } while (0)

    if (IN(0)) { const Ctx Y = fresh(X); build_mod(Y); build_rope(Y); aux1_ktab(Y, 0, 0, 2 * S5G * 8, 0, Y.G); aux1_filt(Y, 0, 0, 256, 0); }
    SEAM(0);
    if (IN(1)) { const Ctx Y = fresh(X); build_modab(Y); aux2(Y, 0); aux2_spec(Y, 0, 0, HYW, 0); combine_norm(Y, 0); }
    SEAM_BG2(1, 0, 0, 1);
    for (int l = 0; l < NLAYER; ++l) {
        const int pb = 2 + 10 * l;
        if (IN(pb + 0)) { for (int rep_ = 0; rep_ < NREP(0); ++rep_) {
            const Ctx Y = fresh(X); unsigned char* ws = Y.ws;
            const pg8::Gemm g{(const bf16_t*)(ws + WS_ACT), (const bf16_t*)(ws + WS_WIN), DM, DM, DM};
            const SchedRM S{7, 136 * 7, Y.G, Y.vcu, 0}; const EpiP E{(bf16_t*)(ws + WS_P), (bf16_t*)(ws + WS_UA), (float*)(ws + WS_SSQP)};
            pg8::gemm_phase<EpiP, SchedRM>(X.lds, g, S, E, X.wave);
            if (l + 1 < NLAYER) { const Ctx Y2 = fresh(X); aux1_ktab(Y2, l + 1, 0, 112, 184, 240); }
            if (l == 0) { const Ctx Y2 = fresh(X); aux1_filt(Y2, 0, 256, 68 * 4, 240); }
        } }
        SEAM_BG(pb + 0, l, 2);
        if (IN(pb + 1)) { for (int rep_ = 0; rep_ < NREP(1); ++rep_) {
            const Ctx Y0 = fresh(X); unsigned char* ws = Y0.ws;
            { const float* rope = (const float*)(ws + WS_ROPE); LAS float* rl = (LAS float*)(X.lds + 131072);
              const float r0 = rope[Y0.tid], r1 = rope[Y0.tid + NTHR]; rl[Y0.tid] = r0; rl[Y0.tid + NTHR] = r1; __syncthreads(); }
            { const pg8::Gemm g{(const bf16_t*)(ws + WS_UA), (const bf16_t*)(ws + WS_WMT), S5K, 1024, 1024};
              const SchedS5 S{1, 48, Y0.G, Y0.vcu, 0, 256}; const EpiS5A E{(float*)(ws + WS_S5S)};
              pg8::gemm_phase<EpiS5A, SchedS5>(X.lds, g, S, E, X.wave); }
            { const int cw = Y0.vcu - 48, cwr = (cw < 0) ? -1 : (cw + 8) % 208;
              { const pg8::Gemm g{(const bf16_t*)(ws + WS_P) + P_CQ, (const bf16_t*)(ws + WS_WUQ), PW, 384, 384};
                const SchedRMW S{3, 136 * 3, 208, cw, 0}; const EpiQ E{(bf16_t*)(ws + WS_Q), (const float*)(ws + WS_SSQP), (const LAS float*)(X.lds + 131072)};
                pg8::gemm_phase<EpiQ, SchedRMW>(X.lds, g, S, E, X.wave); }
              { const pg8::Gemm g{(const bf16_t*)(ws + WS_P) + P_CKV, (const bf16_t*)(ws + WS_WUKV), PW, 256, 256};
                const EpiKV E{(bf16_t*)(ws + WS_KV), (const float*)(ws + WS_SSQP)};
                const bool s5wg = Y0.vcu < 48;
                const SchedRMW S{4, s5wg ? 48 : 136 * 4, s5wg ? 48 : 208, s5wg ? Y0.vcu : cwr, s5wg ? 0 : 48}; pg8::gemm_phase<EpiKV, SchedRMW>(X.lds, g, S, E, X.wave); } }
            if (l + 1 < NLAYER) { const Ctx Y2 = fresh(X); aux1_ktab(Y2, l + 1, 112, 144, 0, 32); }
            for (int r2_ = 0; r2_ < NREP(15); ++r2_) { const Ctx Y = fresh(X); kr_hyprep(Y, l); }
        } }
        SEAM_BG(pb + 1, l, 3);
        if (IN(pb + 2)) {
            { const Ctx Y = fresh(X); s5_scan(Y); }
            const Ctx Y1 = fresh(X); unsigned char* ws = Y1.ws;
            const bf16_t* Q = (const bf16_t*)(ws + WS_Q); const bf16_t* KV = (const bf16_t*)(ws + WS_KV); const bf16_t* KR = (const bf16_t*)(ws + WS_KR); bf16_t* O = (bf16_t*)(ws + WS_MLAO);
            __syncthreads();
            for (int rep_ = 0; rep_ < NREP(2); ++rep_)
            attn::attn_phase(Q, KV, KR, O, Y1.vcu, X.G, (LAS char*)X.lds, X.wave, l + 1 < NLAYER);
            for (int rep_ = 0; rep_ < NREP(12); ++rep_) { const Ctx Y = fresh(X); hyena_conv(Y, l); if (l + 1 < NLAYER) hyena_conv_ctx(Y, l); }
        }
        SEAM_BG(pb + 2, l, 4);
        if (IN(pb + 3)) { for (int rep_ = 0; rep_ < NREP(3); ++rep_) {
            const Ctx Y = fresh(X); unsigned char* ws = Y.ws;
            const pg8::Gemm g{(const bf16_t*)(ws + WS_UA), (const bf16_t*)(ws + WS_TMV), S5K, S5K, S5K};
            const SchedS5 S{4, 192, Y.G, Y.vcu, 0, 1024}; const EpiS5C E{(bf16_t*)(ws + WS_Y1)};
            pg8::gemm_phase<EpiS5C, SchedS5>(X.lds, g, S, E, X.wave);
            if (l + 1 < NLAYER) { const Ctx Y2 = fresh(X); aux1_filt(Y2, l + 1, 0, 64, 192); aux1_ktab(Y2, l + 1, 144, 208, 192, Y2.G); }
        } }
        SEAM_BG(pb + 3, l, 5);
        if (IN(pb + 4)) { for (int rep_ = 0; rep_ < NREP(5); ++rep_) { for (int r2_ = 0; r2_ < NREP(13); ++r2_) { const Ctx Y = fresh(X); merge_groups(Y, l, (l + 1 < NLAYER) ? TT : TL); } } }
        SEAM_BG(pb + 4, l, 6);
        if (IN(pb + 5)) {
            const Ctx Y = fresh(X); unsigned char* ws = Y.ws;
            const pg8::Gemm g{(const bf16_t*)(ws + WS_ACT), (const bf16_t*)(ws + WS_WOUT), DM, DM, DM};
            const SchedRM S{4, ((l + 1 < NLAYER) ? 136 : 128) * 4, Y.G, Y.vcu, 0};
            const float* rs0 = (l == 0) ? Y.a->in[Y.z + I_X] : (const float*)(ws + WS_XL); const float* rs1 = (l == 0) ? Y.a->in[Y.z + I_CTX] - (size_t)TL * DM : (const float*)(ws + WS_XL);
            const EpiOut E{(float*)(ws + WS_XL), (const float*)(ws + WS_MOD) + (size_t)l * 9 * 6144, (float*)(ws + WS_SSQP), rs0, rs1};
            pg8::gemm_phase<EpiOut, SchedRM>(X.lds, g, S, E, X.wave);
            for (int r2_ = 0; r2_ < NREP(19); ++r2_) if (l + 1 < NLAYER) { const Ctx Y2 = fresh(X); aux1_filt(Y2, l + 1, 64, 68 * 4, 32); aux1_ktab(Y2, l + 1, 208, 2 * S5G * 8, 240, Y2.G); }
            if (NREP(23) > 1) { const EpiDown E2{(bf16_t*)(ws + WS_GX)}; pg8::gemm_phase<EpiDown, SchedRM>(X.lds, g, S, E2, X.wave); }
        }
        SEAM(pb + 5);
        if (IN(pb + 6)) { for (int rep_ = 0; rep_ < NREP(7); ++rep_) { { const Ctx Y = fresh(X); norm2_router(Y, l, (l + 1 < NLAYER) ? 136 : 128); } for (int r2_ = 0; r2_ < NREP(18); ++r2_) { const Ctx Y = fresh(X); if (l + 1 < NLAYER) { aux2(Y, l + 1); aux2_spec(Y, l + 1, 0, HYW, 0); } } }
            { const Ctx Y = fresh(X); __syncthreads(); const unsigned done_ = MISC[12]; aux3_left(Y, l, done_); __syncthreads(); if (Y.tid == 0) MISC[12] = 0u; } }
        SEAM(pb + 6);
        if (IN(pb + 7)) { for (int rep_ = 0; rep_ < NREP(9); ++rep_) {
            const Ctx Y = fresh(X); unsigned char* ws = Y.ws;
            moe_table(Y, l);
            const pg8::Gemm g{(const bf16_t*)(ws + WS_ACT), (const bf16_t*)(ws + WS_W13), DM, DM, DM};
            const SchedMoE S{(const LAS int*)(X.lds + MT_OFF), Y.G, Y.vcu, true}; const EpiUp E{(bf16_t*)(ws + WS_HID)};
            pg8::gemm_phase<EpiUp, SchedMoE, true, true, true>(X.lds, g, S, E, X.wave, (const int*)(ws + WS_RTOK));
        } }
        SEAM(pb + 7);
        if (IN(pb + 8)) { for (int rep_ = 0; rep_ < NREP(10); ++rep_) {
            const Ctx Y = fresh(X); unsigned char* ws = Y.ws;
            if (hi - lo == 1) moe_table(Y, l);
            const pg8::Gemm g{(const bf16_t*)(ws + WS_HID), (const bf16_t*)(ws + WS_W2T), MOEH, MOEH, MOEH};
            const SchedMoE S{(const LAS int*)(X.lds + MT_OFF), Y.G, Y.vcu, false}; const EpiDown E{(bf16_t*)(ws + WS_GX)};
            pg8::gemm_phase<EpiDown, SchedMoE>(X.lds, g, S, E, X.wave);
        } }
        SEAM_BG(pb + 8, l + 1, 0);
        if (IN(pb + 9)) { { const Ctx Y = fresh(X); if (hi - lo == 1) moe_table(Y, l); combine_norm(Y, l + 1); } }
        SEAM_BG(pb + 9, l + 1, 1);
    }
#undef IN
#undef SEAM
}

#ifndef MK_CUTS
#define MK_CUTS 0
#endif
extern "C" void kernel_launch(void* const* d_in, const int* in_sizes, int n_in, void* d_out, int out_size, void* d_ws, size_t ws_size, hipStream_t stream) {
    static int grid = 0;
    if (grid == 0) {
        if (n_in != 40 || out_size != TL * DM || ws_size < WS_END) { fprintf(stderr, "kernel_launch: unexpected shapes: n_in %d out %d ws %zu (need %zu)\n", n_in, out_size, ws_size, (size_t)WS_END); grid = -1; return; }
        int dev = 0, cus = 0;
        if (hipGetDevice(&dev) != hipSuccess || hipDeviceGetAttribute(&cus, hipDeviceAttributeMultiprocessorCount, dev) != hipSuccess) { grid = -1; return; }
        if (hipFuncSetAttribute((const void*)fwd, hipFuncAttributeMaxDynamicSharedMemorySize, LDS_BYTES) != hipSuccess) { fprintf(stderr, "kernel_launch: hipFuncSetAttribute failed\n"); grid = -1; return; }
        int per_cu = 0;
        if (hipOccupancyMaxActiveBlocksPerMultiprocessor(&per_cu, (const void*)fwd, NTHR, LDS_BYTES) != hipSuccess || per_cu < 1) { fprintf(stderr, "kernel_launch: occupancy query says %d\n", per_cu); }
        (void)hipGetLastError();
        grid = cus;
    }
    if (grid < 0) return;
    (void)hipMemsetAsync(d_ws, 0, ZERO_BYTES, stream);
    Args a{};
    for (int i = 0; i < 40; ++i) a.in[i] = (const float*)d_in[i];
    a.out = (float*)d_out; a.ws = (unsigned char*)d_ws; a.pad = 0;
#if MK_CUTS
    for (int p = 0; p < NPH; ++p) { a.ph_lo = p; a.ph_hi = p + 1; a.li = p; hipLaunchKernelGGL(fwd, dim3(grid), dim3(NTHR), LDS_BYTES, stream, a); }
#else
    a.ph_lo = 0; a.ph_hi = NPH; a.li = 0; hipLaunchKernelGGL(fwd, dim3(grid), dim3(NTHR), LDS_BYTES, stream, a);
#endif
}
```
